# Optimizing an MI355X kernel written in HIP

```python
import jax, jax.numpy as jnp
from jax import lax
import numpy as np

D_MODEL = 1024
BATCH = 32
SEQ = 2048
DEPTH = 2

N_MIXERS = 2
N_A_LAYERS = (DEPTH + 1) // 2
N_B_LAYERS = DEPTH // 2
RMS_EPS = 1e-6
LRU_WIDTH = D_MODEL
LRU_HEADS = 4
LRU_BLOCK = LRU_WIDTH // LRU_HEADS
CONV_WIDTH = 4
LRU_C = 8.0
RWKV_HEAD = 64
RWKV_HEADS = D_MODEL // RWKV_HEAD
DECAY_LORA = 64
AAA_LORA = 64
GATE_LORA = 128
RWKV_GN_EPS = 64e-5
MEM_LEN = 256
MEM_HEADS = 4
MEM_HEAD_DIM = D_MODEL // MEM_HEADS
D_FF = 4 * D_MODEL

kernel_name = "hybrid_rglru_rwkv7_memxattn"


def rms_norm(x, g):
    xf = x.astype(jnp.float32)
    y = xf * lax.rsqrt(jnp.mean(xf * xf, axis=-1, keepdims=True) + RMS_EPS)
    return (y * g.astype(jnp.float32)).astype(x.dtype)


def _lru_combine(c1, c2):
    a1, b1 = c1
    a2, b2 = c2
    return a1 * a2, a2 * b1 + b2


def rglru_mixer(x, conv_w, conv_b, w_in, b_in, gate_w, gate_b, lam, w_out, b_out):
    B, S, _ = x.shape
    proj = x @ w_in + b_in
    y_branch, u = jnp.split(proj, 2, axis=-1)
    y_branch = jax.nn.gelu(y_branch, approximate=True)
    u_pad = jnp.pad(u, ((0, 0), (CONV_WIDTH - 1, 0), (0, 0)))
    conv = conv_b + u_pad[:, 0:S] * conv_w[0]
    for tap in range(1, CONV_WIDTH):
        conv = conv + u_pad[:, tap:tap + S] * conv_w[tap]
    ub = conv.reshape(B, S, LRU_HEADS, LRU_BLOCK)
    gates = jax.nn.sigmoid(jnp.einsum('bshi,ghij->gbshj', ub, gate_w) + gate_b[:, None, None])
    r_gate = gates[0].reshape(B, S, LRU_WIDTH).astype(jnp.float32)
    i_gate = gates[1].reshape(B, S, LRU_WIDTH).astype(jnp.float32)
    log_a = -LRU_C * r_gate * jax.nn.softplus(-lam.astype(jnp.float32))
    a = jnp.exp(log_a)
    mult = jnp.sqrt(-jnp.expm1(2.0 * log_a))
    b = mult * i_gate * conv.astype(jnp.float32)
    _, h = lax.associative_scan(_lru_combine, (a, b), axis=1)
    return (h.astype(x.dtype) * y_branch) @ w_out + b_out


def rwkv7_mixer(x, mu, w_rkv, w0, w1, w2, a0, a1, a2, g1, g2, k_k, k_a, r_k, gn_g, gn_b, w_o):
    B, S, D = x.shape
    H, N = RWKV_HEADS, RWKV_HEAD
    x_prev = jnp.pad(x, ((0, 0), (1, 0), (0, 0)))[:, :S]
    xx = x_prev - x
    r = (x + xx * mu[0]) @ w_rkv[0]
    xw = x + xx * mu[1]
    k = (x + xx * mu[2]) @ w_rkv[1]
    v = (x + xx * mu[3]) @ w_rkv[2]
    xa = x + xx * mu[4]
    xg = x + xx * mu[5]
    w_log = -jax.nn.softplus(-(w0 + jnp.tanh(xw @ w1) @ w2).astype(jnp.float32)) - 0.5
    decay = jnp.exp(-jnp.exp(w_log))
    a = jax.nn.sigmoid(a0 + (xa @ a1) @ a2)
    g = jax.nn.sigmoid(xg @ g1) @ g2
    kk = (k * k_k).reshape(B, S, H, N).astype(jnp.float32)
    kk = kk / jnp.maximum(jnp.linalg.norm(kk, axis=-1, keepdims=True), 1e-12)
    k = k * (1.0 + (a - 1.0) * k_a)

    rh = r.reshape(B, S, H, N).astype(jnp.float32)
    kh = k.reshape(B, S, H, N).astype(jnp.float32)
    vh = v.reshape(B, S, H, N).astype(jnp.float32)
    wh = decay.reshape(B, S, H, N)
    ah = a.reshape(B, S, H, N).astype(jnp.float32)
    rem_a = -kk
    rem_b = kk * ah

    def step(state, inp):
        r_t, w_t, k_t, v_t, a_t, b_t = inp
        sa = jnp.einsum('bhij,bhj->bhi', state, a_t)
        state = (state * w_t[:, :, None, :] + sa[..., None] * b_t[:, :, None, :]
                 + v_t[..., None] * k_t[:, :, None, :])
        y_t = jnp.einsum('bhij,bhj->bhi', state, r_t)
        return state, y_t

    seq_inputs = tuple(jnp.moveaxis(t, 1, 0) for t in (rh, wh, kh, vh, rem_a, rem_b))
    state0 = jnp.zeros((B, H, N, N), jnp.float32)
    _, ys = lax.scan(step, state0, seq_inputs)
    y = jnp.moveaxis(ys, 0, 1)
    mean = jnp.mean(y, axis=-1, keepdims=True)
    var = jnp.mean(jnp.square(y - mean), axis=-1, keepdims=True)
    yn = ((y - mean) * lax.rsqrt(var + RWKV_GN_EPS)).reshape(B, S, D)
    yn = yn * gn_g.astype(jnp.float32) + gn_b.astype(jnp.float32)
    bonus = jnp.sum(rh * kh * r_k.astype(jnp.float32), axis=-1, keepdims=True) * vh
    out = (yn + bonus.reshape(B, S, D)).astype(x.dtype)
    return (out * g) @ w_o


def mem_cross_attention(h, mem_n, w_q, w_kv, w_o):
    B, S, D = h.shape
    M = mem_n.shape[1]
    q = (h @ w_q).reshape(B, S, MEM_HEADS, MEM_HEAD_DIM)
    kv = (mem_n @ w_kv).reshape(B, M, 2, MEM_HEADS, MEM_HEAD_DIM)
    k, v = kv[:, :, 0], kv[:, :, 1]
    s = jnp.einsum('bqhd,bkhd->bhqk', q, k).astype(jnp.float32) * (MEM_HEAD_DIM ** -0.5)
    p = jax.nn.softmax(s, axis=-1).astype(h.dtype)
    o = jnp.einsum('bhqk,bkhd->bqhd', p, v).reshape(B, S, D)
    return o @ w_o


def sqrelu_mlp(h, w_up, w_down):
    return jnp.square(jax.nn.relu(h @ w_up)) @ w_down


def setup_inputs(seed: int = 0) -> dict:
    key = jax.random.key(seed)
    ks = iter(jax.random.split(key, 48))
    f32 = jnp.float32

    def nrm(shape, scale):
        return jax.random.normal(next(ks), shape, f32) * scale

    def unif(shape, lo, hi):
        return jax.random.uniform(next(ks), shape, f32, lo, hi)

    D, NA, NB = D_MODEL, N_A_LAYERS, N_B_LAYERS
    x = nrm((BATCH, SEQ, D), 1.0)
    mem = nrm((BATCH, MEM_LEN, D), 1.0)
    ln_gains = 1.0 + nrm((DEPTH, 6, D), 0.05)
    mem_norm = 1.0 + nrm((D,), 0.05)
    a_conv_w = nrm((NA, CONV_WIDTH, LRU_WIDTH), CONV_WIDTH ** -0.5)
    a_conv_b = nrm((NA, LRU_WIDTH), 0.01)
    a_w_in = nrm((NA, D, 2 * LRU_WIDTH), D ** -0.5)
    a_b_in = nrm((NA, 2 * LRU_WIDTH), 0.01)
    a_gate_w = nrm((NA, 2, LRU_HEADS, LRU_BLOCK, LRU_BLOCK), LRU_BLOCK ** -0.5)
    a_gate_b = nrm((NA, 2, LRU_HEADS, LRU_BLOCK), 0.01)
    u = unif((NA, LRU_WIDTH), 0.81, 0.998)
    sp = -0.5 * jnp.log(u)
    a_lambda = -jnp.log(jnp.expm1(sp))
    a_w_out = nrm((NA, LRU_WIDTH, D), LRU_WIDTH ** -0.5)
    a_b_out = nrm((NA, D), 0.01)
    b_mu = unif((NB, 6, D), 0.0, 1.0)
    b_w_rkv = nrm((NB, 3, D, D), D ** -0.5)
    b_w0 = unif((NB, D), -6.0, -1.0)
    b_w1 = nrm((NB, D, DECAY_LORA), D ** -0.5)
    b_w2 = nrm((NB, DECAY_LORA, D), 0.1 * DECAY_LORA ** -0.5)
    b_a0 = nrm((NB, D), 0.1)
    b_a1 = nrm((NB, D, AAA_LORA), D ** -0.5)
    b_a2 = nrm((NB, AAA_LORA, D), 0.1 * AAA_LORA ** -0.5)
    b_g1 = nrm((NB, D, GATE_LORA), D ** -0.5)
    b_g2 = nrm((NB, GATE_LORA, D), GATE_LORA ** -0.5)
    b_k_k = 0.85 + nrm((NB, D), 0.05)
    b_k_a = 1.0 + nrm((NB, D), 0.05)
    b_r_k = nrm((NB, RWKV_HEADS, RWKV_HEAD), 0.1)
    b_gn_g = 1.0 + nrm((NB, D), 0.05)
    b_gn_b = nrm((NB, D), 0.01)
    b_w_o = nrm((NB, D, D), D ** -0.5)
    c_w_q = nrm((DEPTH, D, D), D ** -0.5)
    c_w_kv = nrm((DEPTH, D, 2 * D), D ** -0.5)
    c_w_o = nrm((DEPTH, D, D), D ** -0.5)
    m_w_up = nrm((DEPTH, D, D_FF), D ** -0.5)
    m_w_down = nrm((DEPTH, D_FF, D), D_FF ** -0.5)
    return {"x": x, "mem": mem, "ln_gains": ln_gains, "mem_norm": mem_norm,
            "a_conv_w": a_conv_w, "a_conv_b": a_conv_b, "a_w_in": a_w_in, "a_b_in": a_b_in,
            "a_gate_w": a_gate_w, "a_gate_b": a_gate_b, "a_lambda": a_lambda,
            "a_w_out": a_w_out, "a_b_out": a_b_out,
            "b_mu": b_mu, "b_w_rkv": b_w_rkv, "b_w0": b_w0, "b_w1": b_w1, "b_w2": b_w2,
            "b_a0": b_a0, "b_a1": b_a1, "b_a2": b_a2, "b_g1": b_g1, "b_g2": b_g2,
            "b_k_k": b_k_k, "b_k_a": b_k_a, "b_r_k": b_r_k, "b_gn_g": b_gn_g, "b_gn_b": b_gn_b,
            "b_w_o": b_w_o,
            "c_w_q": c_w_q, "c_w_kv": c_w_kv, "c_w_o": c_w_o,
            "m_w_up": m_w_up, "m_w_down": m_w_down}


def reference(x, mem, ln_gains, mem_norm,
              a_conv_w, a_conv_b, a_w_in, a_b_in, a_gate_w, a_gate_b, a_lambda, a_w_out, a_b_out,
              b_mu, b_w_rkv, b_w0, b_w1, b_w2, b_a0, b_a1, b_a2, b_g1, b_g2,
              b_k_k, b_k_a, b_r_k, b_gn_g, b_gn_b, b_w_o,
              c_w_q, c_w_kv, c_w_o, m_w_up, m_w_down):
    mem_n = rms_norm(mem, mem_norm)
    for i in range(DEPTH):
        g = ln_gains[i]
        j = i // N_MIXERS
        hn = rms_norm(x, g[0])
        if i % N_MIXERS == 0:
            t = rglru_mixer(hn, a_conv_w[j], a_conv_b[j], a_w_in[j], a_b_in[j], a_gate_w[j],
                            a_gate_b[j], a_lambda[j], a_w_out[j], a_b_out[j])
        else:
            t = rwkv7_mixer(hn, b_mu[j], b_w_rkv[j], b_w0[j], b_w1[j], b_w2[j], b_a0[j],
                            b_a1[j], b_a2[j], b_g1[j], b_g2[j], b_k_k[j], b_k_a[j], b_r_k[j],
                            b_gn_g[j], b_gn_b[j], b_w_o[j])
        x = x + rms_norm(t, g[1])
        c = mem_cross_attention(rms_norm(x, g[2]), mem_n, c_w_q[i], c_w_kv[i], c_w_o[i])
        x = x + rms_norm(c, g[3])
        m = sqrelu_mlp(rms_norm(x, g[4]), m_w_up[i], m_w_down[i])
        x = x + rms_norm(m, g[5])
    return x
```

```cpp
#include <hip/hip_runtime.h>
#include <hip/hip_cooperative_groups.h>
#include <cstdio>
#include <cstdint>
namespace cg = cooperative_groups;

#define LAS __attribute__((address_space(3)))
#define GAS __attribute__((address_space(1)))
typedef unsigned short bf16_t;
typedef short bf16x8 __attribute__((ext_vector_type(8)));
typedef float f32x4 __attribute__((ext_vector_type(4)));
typedef float f32x2 __attribute__((ext_vector_type(2)));
typedef unsigned u32x4 __attribute__((ext_vector_type(4)));
typedef unsigned u32x2 __attribute__((ext_vector_type(2)));

constexpr int T_TOK = 65536, DM = 1024, SEQ = 2048, NBATCH = 32;
constexpr float RMS_EPS = 1e-6f;
constexpr size_t MiB = 1u << 20;
constexpr size_t SLOT = 128 * MiB;
constexpr size_t WS_MISC = 7 * SLOT;
constexpr size_t MO_WIN = 0, MO_WGATE = 4 * MiB, MO_WOUT = 5 * MiB, MO_WRKV = 7 * MiB, MO_WL2 = 20 * MiB, MO_WBO = 22 * MiB,
                 MO_WQ = 24 * MiB, MO_WKV = 28 * MiB, MO_WCO = 36 * MiB, MO_WUP = 40 * MiB, MO_WDN = 56 * MiB, MO_MEMN = 72 * MiB,
                 MO_KMEM = 88 * MiB, MO_VTMEM = 104 * MiB, MO_SP = 120 * MiB;
constexpr size_t WS_NEED = WS_MISC + 122 * MiB;
constexpr int LDS_BYTES = 147456, LDS_MISC_OFF = 131072;

struct Params { const float* in[34]; float* out; unsigned char* ws; };

__device__ __forceinline__ unsigned cvt_pk_bf16(float lo, float hi) { unsigned r; asm("v_cvt_pk_bf16_f32 %0, %1, %2" : "=v"(r) : "v"(lo), "v"(hi)); return r; }
__device__ __forceinline__ float bf_lo(unsigned w) { return __uint_as_float(w << 16); }
__device__ __forceinline__ float bf_hi(unsigned w) { return __uint_as_float(w & 0xffff0000u); }
__device__ __forceinline__ f32x4 unpack4(u32x2 w) { return (f32x4){bf_lo(w.x), bf_hi(w.x), bf_lo(w.y), bf_hi(w.y)}; }
__device__ __forceinline__ u32x2 pack4(f32x4 v) { u32x2 o; o.x = cvt_pk_bf16(v.x, v.y); o.y = cvt_pk_bf16(v.z, v.w); return o; }
__device__ __forceinline__ u32x4 pack8(f32x4 a, f32x4 b) { u32x4 o; o.x = cvt_pk_bf16(a.x, a.y); o.y = cvt_pk_bf16(a.z, a.w); o.z = cvt_pk_bf16(b.x, b.y); o.w = cvt_pk_bf16(b.z, b.w); return o; }
__device__ __forceinline__ float wave_sum(float v) {
#pragma unroll
    for (int o = 1; o < 64; o <<= 1) v += __shfl_xor(v, o);
    return v;
}
__device__ __forceinline__ float sum16(float v) {
    float a = v + __builtin_bit_cast(float, __builtin_amdgcn_mov_dpp(__builtin_bit_cast(int, v), 0xB1, 0xF, 0xF, true));
    a = a + __builtin_bit_cast(float, __builtin_amdgcn_mov_dpp(__builtin_bit_cast(int, a), 0x4E, 0xF, 0xF, true));
    a = a + __builtin_bit_cast(float, __builtin_amdgcn_mov_dpp(__builtin_bit_cast(int, a), 0x141, 0xF, 0xF, true));
    return a + __builtin_bit_cast(float, __builtin_amdgcn_mov_dpp(__builtin_bit_cast(int, a), 0x140, 0xF, 0xF, true));
}
__device__ __forceinline__ float quad_sum(float v) {
    float a = v + __builtin_bit_cast(float, __builtin_amdgcn_mov_dpp(__builtin_bit_cast(int, v), 0xB1, 0xF, 0xF, true));
    return a + __builtin_bit_cast(float, __builtin_amdgcn_mov_dpp(__builtin_bit_cast(int, a), 0x4E, 0xF, 0xF, true));
}
__device__ __forceinline__ int lane_opaque() { unsigned m = ~0u; asm volatile("" : "+s"(m)); int l = (int)__builtin_amdgcn_mbcnt_hi(m, __builtin_amdgcn_mbcnt_lo(m, 0u)); asm volatile("" : "+v"(l)); return l; }
__device__ __forceinline__ void grid_bar(unsigned* ctr, unsigned target, int wave) {
    asm volatile("s_waitcnt vmcnt(0) lgkmcnt(0)" ::: "memory");
    __builtin_amdgcn_s_barrier();
    if (wave == 0) {
        if (lane_opaque() == 0) {
            __builtin_amdgcn_fence(__ATOMIC_RELEASE, "agent");
            asm volatile("s_waitcnt vmcnt(0)" ::: "memory");
            __hip_atomic_fetch_add(ctr, 1u, __ATOMIC_RELAXED, __HIP_MEMORY_SCOPE_AGENT);
            unsigned spins = 0;
            while (__hip_atomic_load(ctr, __ATOMIC_RELAXED, __HIP_MEMORY_SCOPE_AGENT) < target) { __builtin_amdgcn_s_sleep(2); if (++spins > (1u << 23)) break; }
            __builtin_amdgcn_fence(__ATOMIC_ACQUIRE, "agent");
            asm volatile("s_waitcnt vmcnt(0)" ::: "memory");
        }
    }
    asm volatile("" ::: "memory");
    __builtin_amdgcn_s_barrier();
    asm volatile("" ::: "memory");
}
__device__ __forceinline__ float oct_sum(float v) {
    float a = quad_sum(v);
    return a + __builtin_bit_cast(float, __builtin_amdgcn_mov_dpp(__builtin_bit_cast(int, a), 0x141, 0xF, 0xF, true));
}
typedef _Float16 h16x2 __attribute__((ext_vector_type(2)));
__device__ __forceinline__ unsigned pk_h2(float lo, float hi) { f32x2 v = {lo, hi}; h16x2 h = __builtin_convertvector(v, h16x2); return __builtin_bit_cast(unsigned, h); }
__device__ __forceinline__ f32x4 unpack4h(u32x2 w) { const h16x2 a = __builtin_bit_cast(h16x2, w.x), b = __builtin_bit_cast(h16x2, w.y); return (f32x4){(float)a.x, (float)a.y, (float)b.x, (float)b.y}; }
__device__ __forceinline__ float row_scan16(float x) {
    x += __builtin_bit_cast(float, __builtin_amdgcn_update_dpp(0, __builtin_bit_cast(int, x), 0x111, 0xF, 0xF, false));
    x += __builtin_bit_cast(float, __builtin_amdgcn_update_dpp(0, __builtin_bit_cast(int, x), 0x112, 0xF, 0xF, false));
    x += __builtin_bit_cast(float, __builtin_amdgcn_update_dpp(0, __builtin_bit_cast(int, x), 0x114, 0xF, 0xF, false));
    x += __builtin_bit_cast(float, __builtin_amdgcn_update_dpp(0, __builtin_bit_cast(int, x), 0x118, 0xF, 0xF, false));
    return x;
}
__device__ __forceinline__ float sigm(float x) { return __builtin_amdgcn_rcpf(1.f + __expf(-x)); }
__device__ __forceinline__ float tanh_(float x) { return 1.f - 2.f * __builtin_amdgcn_rcpf(1.f + __expf(2.f * x)); }
__device__ __forceinline__ float gelu_tanh(float x) { return x * __builtin_amdgcn_rcpf(1.f + __expf(-1.5957691216f * (x + 0.044715f * x * x * x))); }
__device__ __forceinline__ float dot4(f32x4 a, f32x4 b) { return (a.x * b.x + a.y * b.y) + (a.z * b.z + a.w * b.w); }

namespace pg8 {
constexpr int BM = 256, BK = 64, HALF = 128, HTB = HALF * BK * 2, STAGE_BYTES = 8 * HTB, NXCD = 8, WGM = 8;
__device__ __forceinline__ int lds_byte(int r, int c) { const int st = (r >> 4) * 2 + (c >> 5), rr = r & 15, cc = c & 31, ob = rr * 64 + cc * 2; return st * 1024 + (ob ^ (((ob >> 9) & 1) << 5)); }
__device__ __forceinline__ void stage_rc(int b, int& R, int& C) { const int st = b / 1024, sb = b % 1024, swz = sb ^ (((sb >> 9) & 1) << 5); R = (st >> 1) * 16 + swz / 64; C = (st & 1) * 32 + (swz % 64) / 2; }
__device__ __forceinline__ int perm32(int rho) { const int n = rho >> 4, i = rho & 15; return 8 * (i >> 2) + 4 * n + (i & 3); }

struct Unit { int pm, pn; };
struct Gemm { const bf16_t* A; const bf16_t* B; int lda, ldb, K, acol_on, acol_shift, bbatch; };

struct Order {
    int nM, nN, nwg, G, c, panel;
    __device__ void init(int nM_, int nN_, int G_, int c_, int panel_ = 0) { nM = nM_; nN = nN_; nwg = nM * nN; G = G_; c = c_; panel = panel_; }
    __device__ bool next(int i, Unit& u) const {
        if (panel) { if (i >= nN || c >= nM) return false; u.pm = c; u.pn = i; return true; }
        const long L = (long)i * G + c; if (L >= nwg) return false;
        int wgid = (int)L; { const int q = nwg / NXCD, r = nwg % NXCD, xcd = wgid % NXCD, off = wgid / NXCD; wgid = (xcd < r ? xcd * (q + 1) : r * (q + 1) + (xcd - r) * q) + off; }
        const int nig = WGM * nN, gid = wgid / nig, fm = gid * WGM, gsz = (nM - fm) < WGM ? (nM - fm) : WGM;
        u.pm = fm + ((wgid % nig) % gsz); u.pn = (wgid % nig) / gsz; return true;
    }
};

template <class Epi, bool ALIGN_EPI>
__device__ __forceinline__ void gemm_phase(LAS unsigned char* lds, const Gemm g, const Order& S, const Epi& E, int wave) {
    const int lane = lane_opaque(), wid = wave, tid = wid * 64 + lane, wr = wid >> 2, wc = wid & 3, fr = lane & 15, fq = lane >> 4;
    const int nt = g.K / BK;
    unsigned voffA[2], voffB[2];
#pragma unroll
    for (int i = 0; i < 2; ++i) { int R, C; stage_rc(tid * 16 + i * 8192, R, C); const int Rb = (R & ~31) + perm32(R & 31);
        voffA[i] = (unsigned)(R * g.lda + C) * 2u; voffB[i] = (unsigned)(Rb * g.ldb + C) * 2u; }
    const size_t kstep = (size_t)(BK * 2);
    const size_t hstepA = (size_t)HALF * g.lda * 2, hstepB = (size_t)HALF * g.ldb * 2;
    const unsigned ldsw = (unsigned)wid * 1024u;
    const int aoff = lds_byte(wr * 64 + fr, fq * 8), boff = lds_byte(wc * 32 + fr, fq * 8);
#define PG8_APTR(u) ((const char*)g.A + ((size_t)(u).pm * 256 * g.lda + (g.acol_on ? (size_t)(((u).pn >> g.acol_shift) * 256) : (size_t)0)) * 2)
#define PG8_BPTR(u) ((const char*)g.B + (size_t)(((u).pm >> 3) * g.bbatch + (u).pn) * 256 * g.ldb * 2)
#define PG8_SA(b, h) (((b) * 2 + (h)) * HTB)
#define PG8_SB(b, h) ((4 + (b) * 2 + (h)) * HTB)
#define PG8_STAGE(bufoff, gbase, voff) do { _Pragma("unroll") for (int _i = 0; _i < 2; ++_i) \
        __builtin_amdgcn_global_load_lds((const unsigned*)((const char*)(gbase) + (voff)[_i]), (LAS unsigned*)(lds + (bufoff) + ldsw + _i * 8192), 16, 0, 0); } while (0)
#define PG8_LDA(dst, b, h) do { _Pragma("unroll") for (int m = 0; m < 4; ++m) _Pragma("unroll") for (int k = 0; k < 2; ++k) dst[m][k] = *(const LAS bf16x8*)(lds + PG8_SA(b, h) + aoff + m * 2048 + k * 1024); } while (0)
#define PG8_LDB(dst, b, h) do { _Pragma("unroll") for (int n = 0; n < 2; ++n) _Pragma("unroll") for (int k = 0; k < 2; ++k) dst[n][k] = *(const LAS bf16x8*)(lds + PG8_SB(b, h) + boff + n * 2048 + k * 1024); } while (0)
#define PG8_MMA(ai, bj, At, Bt) do { __builtin_amdgcn_s_setprio(1); _Pragma("unroll") for (int m = 0; m < 4; ++m) _Pragma("unroll") for (int n = 0; n < 2; ++n) _Pragma("unroll") for (int k = 0; k < 2; ++k) \
        acc[ai][bj][m][n] = __builtin_amdgcn_mfma_f32_16x16x32_bf16(Bt[n][k], At[m][k], acc[ai][bj][m][n], 0, 0, 0); __builtin_amdgcn_s_setprio(0); } while (0)
#define PG8_WAIT_V(n) asm volatile("s_waitcnt vmcnt(" #n ")" ::: "memory")
#define PG8_WAIT_L(n) asm volatile("s_waitcnt lgkmcnt(" #n ")" ::: "memory")
#define PG8_BAR __builtin_amdgcn_s_barrier()
#define PG8_SCHED __builtin_amdgcn_sched_barrier(0)
    Unit cur, nxt; int ui = 0;
    if (!S.next(0, cur)) return;
    f32x4 acc[2][2][4][2];
#pragma unroll
    for (int a = 0; a < 2; ++a)
#pragma unroll
        for (int b = 0; b < 2; ++b)
#pragma unroll
            for (int m = 0; m < 4; ++m)
#pragma unroll
                for (int n = 0; n < 2; ++n) acc[a][b][m][n] = (f32x4){0.f, 0.f, 0.f, 0.f};
    bf16x8 At[4][2], B0[2][2], B1[2][2];
    const char* cA = PG8_APTR(cur); const char* cB = PG8_BPTR(cur);
    PG8_STAGE(PG8_SB(0, 0), cB, voffB); PG8_STAGE(PG8_SB(0, 1), cB + hstepB, voffB); PG8_STAGE(PG8_SA(0, 0), cA, voffA); PG8_STAGE(PG8_SA(0, 1), cA + hstepA, voffA);
    if (wr == 1) PG8_BAR;
    PG8_WAIT_V(2); PG8_BAR;
    PG8_STAGE(PG8_SB(1, 0), cB + kstep, voffB); PG8_STAGE(PG8_SA(1, 0), cA + kstep, voffA); PG8_STAGE(PG8_SB(1, 1), cB + hstepB + kstep, voffB);
    PG8_WAIT_V(6); PG8_BAR;
    for (;;) {
        const bool has_next = S.next(ui + 1, nxt);
        const char* nA = has_next ? PG8_APTR(nxt) : cA; const char* nB = has_next ? PG8_BPTR(nxt) : cB;
#pragma unroll 1
        for (int t = 0; t < nt; t += 2) {
            const bool last = (t == nt - 2);
            const char* a1 = cA + (size_t)(t + 1) * kstep;
            const char* a2 = last ? nA : cA + (size_t)(t + 2) * kstep; const char* b2 = last ? nB : cB + (size_t)(t + 2) * kstep;
            const char* a3 = a2 + kstep; const char* b3 = b2 + kstep;
            PG8_LDB(B0, 0, 0); PG8_LDB(B1, 0, 1); PG8_SCHED; PG8_LDA(At, 0, 0); PG8_STAGE(PG8_SA(1, 1), a1 + hstepA, voffA);
            PG8_WAIT_V(8); PG8_WAIT_L(0); PG8_BAR; PG8_MMA(0, 0, At, B0); PG8_MMA(0, 1, At, B1); PG8_BAR; PG8_SCHED;
            PG8_LDA(At, 0, 1); PG8_STAGE(PG8_SB(0, 0), b2, voffB); PG8_STAGE(PG8_SB(0, 1), b2 + hstepB, voffB); PG8_STAGE(PG8_SA(0, 0), a2, voffA);
            PG8_WAIT_V(8); PG8_WAIT_L(0); PG8_BAR; PG8_MMA(1, 0, At, B0); PG8_MMA(1, 1, At, B1); PG8_BAR; PG8_SCHED;
            PG8_LDB(B0, 1, 0); PG8_LDB(B1, 1, 1); PG8_SCHED; PG8_LDA(At, 1, 0); PG8_STAGE(PG8_SA(0, 1), a2 + hstepA, voffA);
            PG8_WAIT_V(8); PG8_WAIT_L(0); PG8_BAR; PG8_MMA(0, 0, At, B0); PG8_MMA(0, 1, At, B1); PG8_BAR; PG8_SCHED;
            PG8_LDA(At, 1, 1); PG8_STAGE(PG8_SB(1, 0), b3, voffB); PG8_STAGE(PG8_SB(1, 1), b3 + hstepB, voffB); PG8_STAGE(PG8_SA(1, 0), a3, voffA);
            PG8_WAIT_V(8); PG8_WAIT_L(0); PG8_BAR; PG8_MMA(1, 0, At, B0); PG8_MMA(1, 1, At, B1); PG8_BAR; PG8_SCHED;
        }
        if constexpr (ALIGN_EPI) { if (wr == 0) PG8_BAR; }
        E(acc, cur, wr, wc, fr, fq, lds + LDS_MISC_OFF);
        if (!has_next) break;
#pragma unroll
        for (int a = 0; a < 2; ++a)
#pragma unroll
            for (int b = 0; b < 2; ++b)
#pragma unroll
                for (int m = 0; m < 4; ++m)
#pragma unroll
                    for (int n = 0; n < 2; ++n) acc[a][b][m][n] = (f32x4){0.f, 0.f, 0.f, 0.f};
        cur = nxt; cA = nA; cB = nB; ++ui;
        if constexpr (ALIGN_EPI) { if (wr == 1) PG8_BAR; }
    }
    PG8_WAIT_V(0);
    if constexpr (!ALIGN_EPI) { if (wr == 0) PG8_BAR; }
    PG8_BAR;
#undef PG8_APTR
#undef PG8_BPTR
#undef PG8_SA
#undef PG8_SB
#undef PG8_STAGE
#undef PG8_LDA
#undef PG8_LDB
#undef PG8_MMA
#undef PG8_WAIT_V
#undef PG8_WAIT_L
#undef PG8_BAR
#undef PG8_SCHED
}

template <class F> struct Epi {
    F f;
    __device__ __forceinline__ void operator()(f32x4 (&acc)[2][2][4][2], const Unit& u, int wr, int wc, int fr, int fq, LAS unsigned char*) const {
        asm volatile("" : "+v"(fr), "+v"(fq));
#pragma unroll
        for (int ai = 0; ai < 2; ++ai)
#pragma unroll
            for (int m = 0; m < 4; ++m) {
                const int r = ai * HALF + wr * 64 + m * 16 + fr;
#pragma unroll
                for (int bj = 0; bj < 2; ++bj) f.emit(u, r, bj * HALF + wc * 32 + 8 * fq, acc[ai][bj][m][0], acc[ai][bj][m][1]);
            }
    }
};
}
using pg8::Unit;

template <int ACT> struct FStd {
    bf16_t* dst; int ldc; const float* bias; float scale;
    __device__ __forceinline__ void emit(const Unit& u, int r, int c0, f32x4 v0, f32x4 v1) const {
        const int col = u.pn * 256 + c0; const size_t row = (size_t)u.pm * 256 + r;
        if (bias) { v0 += *(const GAS f32x4*)(bias + col); v1 += *(const GAS f32x4*)(bias + col + 4); }
        v0 *= scale; v1 *= scale;
        if (ACT == 1) {
#pragma unroll
            for (int e = 0; e < 4; ++e) { float a = fmaxf(v0[e], 0.f); v0[e] = a * a; float b = fmaxf(v1[e], 0.f); v1[e] = b * b; }
        }
        *(GAS u32x4*)(dst + row * ldc + col) = pack8(v0, v1);
    }
};
struct FTile {
    bf16_t* dst; int mulm, muln;
    __device__ __forceinline__ void emit(const Unit& u, int r, int c0, f32x4 v0, f32x4 v1) const {
        *(GAS u32x4*)(dst + (size_t)(u.pm * mulm + u.pn * muln) * 65536 + r * 256 + c0) = pack8(v0, v1);
    }
};
struct FWin {
    bf16_t* Y; bf16_t* U; const float* bias;
    __device__ __forceinline__ void emit(const Unit& u, int r, int c0, f32x4 v0, f32x4 v1) const {
        const int col = u.pn * 256 + c0; const size_t row = (size_t)u.pm * 256 + r;
        v0 += *(const GAS f32x4*)(bias + col); v1 += *(const GAS f32x4*)(bias + col + 4);
        if (u.pn < 4) {
#pragma unroll
            for (int e = 0; e < 4; ++e) { v0[e] = gelu_tanh(v0[e]); v1[e] = gelu_tanh(v1[e]); }
            *(GAS u32x4*)(Y + row * 1024 + col) = pack8(v0, v1);
        } else *(GAS u32x4*)(U + row * 1024 + (col - 1024)) = pack8(v0, v1);
    }
};
struct FLora {
    bf16_t* L;
    __device__ __forceinline__ void emit(const Unit& u, int r, int c0, f32x4 v0, f32x4 v1) const {
        const size_t row = (size_t)u.pm * 256 + r;
        if (c0 < 64) {
#pragma unroll
            for (int e = 0; e < 4; ++e) { v0[e] = tanh_(v0[e]); v1[e] = tanh_(v1[e]); }
        } else if (c0 >= 128) {
#pragma unroll
            for (int e = 0; e < 4; ++e) { v0[e] = sigm(v0[e]); v1[e] = sigm(v1[e]); }
        }
        *(GAS u32x4*)(L + row * 1024 + c0) = pack8(v0, v1);
    }
};
struct FL2 {
    unsigned char* ws; const float* w0; const float* a0;
    __device__ __forceinline__ void emit(const Unit& u, int r, int c0, f32x4 v0, f32x4 v1) const {
        const size_t row = (size_t)u.pm * 256 + r; const int ch = (u.pn & 3) * 256 + c0; const int w = u.pn >> 2;
        bf16_t* d = (bf16_t*)(ws + (size_t)(3 + w) * SLOT);
        if (w == 0) { v0 += *(const GAS f32x4*)(w0 + ch); v1 += *(const GAS f32x4*)(w0 + ch + 4);
#pragma unroll
            for (int e = 0; e < 4; ++e) { v0[e] = 0.60653066f * sigm(v0[e]); v1[e] = 0.60653066f * sigm(v1[e]); }
#pragma unroll
            for (int e = 0; e < 4; ++e) { v0[e] = row_scan16(v0[e]); v1[e] = row_scan16(v1[e]); }
            *(GAS u32x4*)(d + row * 1024 + ch) = pack8(v0, v1);
            return;
            }
        else if (w == 1) { v0 += *(const GAS f32x4*)(a0 + ch); v1 += *(const GAS f32x4*)(a0 + ch + 4);
#pragma unroll
            for (int e = 0; e < 4; ++e) { v0[e] = sigm(v0[e]); v1[e] = sigm(v1[e]); }
            }
        *(GAS u32x4*)(d + row * 1024 + ch) = pack8(v0, v1);
    }
};
struct EpiGate {
    const bf16_t* C; const float* gate_b; const float* sp; bf16_t* LA; bf16_t* BV;
    __device__ __forceinline__ void operator()(f32x4 (&acc)[2][2][4][2], const Unit& u, int wr, int wc, int fr, int fq, LAS unsigned char*) const {
        asm volatile("" : "+v"(fr), "+v"(fq));
        const int ch0 = (u.pn >> 1) * 256 + (u.pn & 1) * 128 + wc * 32 + 8 * fq;
        f32x4 br[2], bi[2], s[2];
#pragma unroll
        for (int n = 0; n < 2; ++n) { br[n] = *(const GAS f32x4*)(gate_b + ch0 + 4 * n); bi[n] = *(const GAS f32x4*)(gate_b + 1024 + ch0 + 4 * n); s[n] = *(const GAS f32x4*)(sp + ch0 + 4 * n); }
#pragma unroll
        for (int ai = 0; ai < 2; ++ai)
#pragma unroll
            for (int m = 0; m < 4; ++m) {
                const size_t row = (size_t)u.pm * 256 + ai * 128 + wr * 64 + m * 16 + fr;
                const u32x4 cw = *(const GAS u32x4*)(C + row * 1024 + ch0);
                f32x4 cv[2]; cv[0] = (f32x4){bf_lo(cw.x), bf_hi(cw.x), bf_lo(cw.y), bf_hi(cw.y)}; cv[1] = (f32x4){bf_lo(cw.z), bf_hi(cw.z), bf_lo(cw.w), bf_hi(cw.w)};
                f32x4 la[2], bb[2];
#pragma unroll
                for (int n = 0; n < 2; ++n)
#pragma unroll
                    for (int e = 0; e < 4; ++e) {
                        const float rg = sigm(acc[ai][0][m][n][e] + br[n][e]), ig = sigm(acc[ai][1][m][n][e] + bi[n][e]);
                        const float l = -8.0f * rg * s[n][e];
                        const float mult = sqrtf(fmaxf(1.f - __expf(2.f * l), 0.f));
                        la[n][e] = l; bb[n][e] = mult * ig * cv[n][e];
                    }
                *(GAS u32x4*)(LA + row * 1024 + ch0) = pack8(la[0], la[1]);
                *(GAS u32x4*)(BV + row * 1024 + ch0) = pack8(bb[0], bb[1]);
            }
    }
};
struct EpiSoftmax {
    bf16_t* P;
    __device__ __forceinline__ void operator()(f32x4 (&acc)[2][2][4][2], const Unit& u, int wr, int wc, int fr, int fq, LAS unsigned char* lm) const {
        asm volatile("" : "+v"(fr), "+v"(fq));
        LAS float* xmax = (LAS float*)lm; LAS float* xsum = (LAS float*)(lm + 4096);
#pragma unroll
        for (int ai = 0; ai < 2; ++ai)
#pragma unroll
            for (int m = 0; m < 4; ++m) {
                float mx = -3.0e38f;
#pragma unroll
                for (int bj = 0; bj < 2; ++bj)
#pragma unroll
                    for (int n = 0; n < 2; ++n)
#pragma unroll
                        for (int e = 0; e < 4; ++e) mx = fmaxf(mx, acc[ai][bj][m][n][e]);
                mx = fmaxf(mx, __shfl_xor(mx, 16)); mx = fmaxf(mx, __shfl_xor(mx, 32));
                if (fq == 0) xmax[(ai * 128 + wr * 64 + m * 16 + fr) * 4 + wc] = mx;
            }
        asm volatile("s_waitcnt lgkmcnt(0)" ::: "memory"); __builtin_amdgcn_s_barrier(); asm volatile("" ::: "memory");
#pragma unroll
        for (int ai = 0; ai < 2; ++ai)
#pragma unroll
            for (int m = 0; m < 4; ++m) {
                const int r = ai * 128 + wr * 64 + m * 16 + fr;
                const f32x4 mv = *(const LAS f32x4*)(xmax + r * 4);
                const float M = fmaxf(fmaxf(mv.x, mv.y), fmaxf(mv.z, mv.w));
                float sm = 0.f;
#pragma unroll
                for (int bj = 0; bj < 2; ++bj)
#pragma unroll
                    for (int n = 0; n < 2; ++n)
#pragma unroll
                        for (int e = 0; e < 4; ++e) { const float q = __expf(acc[ai][bj][m][n][e] - M); acc[ai][bj][m][n][e] = q; sm += q; }
                sm += __shfl_xor(sm, 16); sm += __shfl_xor(sm, 32);
                if (fq == 0) xsum[r * 4 + wc] = sm;
            }
        asm volatile("s_waitcnt lgkmcnt(0)" ::: "memory"); __builtin_amdgcn_s_barrier(); asm volatile("" ::: "memory");
#pragma unroll
        for (int ai = 0; ai < 2; ++ai)
#pragma unroll
            for (int m = 0; m < 4; ++m) {
                const int r = ai * 128 + wr * 64 + m * 16 + fr;
                const f32x4 sv = *(const LAS f32x4*)(xsum + r * 4);
                const float inv = 1.0f / ((sv.x + sv.y) + (sv.z + sv.w));
                bf16_t* rowp = P + ((size_t)u.pm * 256 + r) * 1024 + u.pn * 256 + wc * 32 + 8 * fq;
#pragma unroll
                for (int bj = 0; bj < 2; ++bj) {
                    *(GAS u32x4*)(rowp + bj * 128) = pack8(acc[ai][bj][m][0] * inv, acc[ai][bj][m][1] * inv);
                }
            }
    }
};

struct TJob { const float* W; int ldw, K, N; bf16_t* WT; int ldwt, row_off, col_off; const float* mu; float s0, s1; };

__device__ __forceinline__ void get_job(int j, const Params& p, TJob& J) {
    bf16_t* mb = (bf16_t*)(p.ws + WS_MISC);
    J.mu = nullptr; J.s0 = 1.f; J.s1 = 0.f; J.row_off = 0; J.col_off = 0;
    if (j == 0) { J.W = p.in[6]; J.ldw = 2048; J.K = 1024; J.N = 2048; J.WT = mb + MO_WIN / 2; J.ldwt = 1024; }
    else if (j < 17) { const int idx = j - 1, gg = idx >> 3, h = (idx >> 1) & 3, half = idx & 1;
        J.W = p.in[8] + (size_t)(gg * 4 + h) * 65536 + half * 128; J.ldw = 256; J.K = 256; J.N = 128; J.WT = mb + MO_WGATE / 2; J.ldwt = 256; J.row_off = (h * 2 + half) * 256 + gg * 128; }
    else if (j == 17) { J.W = p.in[11]; J.ldw = 1024; J.K = 1024; J.N = 1024; J.WT = mb + MO_WOUT / 2; J.ldwt = 1024; }
    else if (j < 24) { const int idx = j - 18, m = idx >> 1, part = idx & 1; const int mi = (m == 0) ? 0 : (m == 1 ? 2 : 3);
        J.W = p.in[14] + (size_t)m * 1048576; J.ldw = 1024; J.K = part ? 0 : 1024; J.N = 1024; J.WT = mb + MO_WRKV / 2; J.ldwt = 1024; J.row_off = m * 1024; (void)mi; }
    else if (j < 30) { const int idx = j - 24, w = idx >> 1, part = idx & 1;
        J.W = (w == 0) ? p.in[16] : (w == 1 ? p.in[19] : p.in[21]); J.N = (w == 2) ? 128 : 64; J.ldw = J.N; J.K = 1024; J.WT = mb + (MO_WRKV + 6 * MiB) / 2; J.ldwt = 2048;
        J.row_off = w * 64; J.col_off = part * 1024; J.mu = p.in[13] + ((w == 0) ? 1 : (w == 1 ? 4 : 5)) * 1024; J.s0 = part ? 0.f : 1.f; J.s1 = part ? 1.f : -1.f; }
    else if (j < 33) { const int w = j - 30;
        J.W = (w == 0) ? p.in[17] : (w == 1 ? p.in[20] : p.in[22]); J.ldw = 1024; J.K = (w == 2) ? 128 : 64; J.N = 1024; J.WT = mb + MO_WL2 / 2; J.ldwt = 256; J.row_off = w * 1024; J.col_off = w * 64; }
    else if (j == 33) { J.W = p.in[28]; J.ldw = 1024; J.K = 1024; J.N = 1024; J.WT = mb + MO_WBO / 2; J.ldwt = 1024; }
    else { const int idx = j - 34, l = idx / 5, kind = idx % 5;
        if (kind == 0)      { J.W = p.in[29] + (size_t)l * 1048576; J.ldw = 1024; J.K = 1024; J.N = 1024; J.WT = mb + MO_WQ / 2 + (size_t)l * 1048576; J.ldwt = 1024; }
        else if (kind == 1) { J.W = p.in[30] + (size_t)l * 2097152; J.ldw = 2048; J.K = 1024; J.N = 2048; J.WT = mb + MO_WKV / 2 + (size_t)l * 2097152; J.ldwt = 1024; }
        else if (kind == 2) { J.W = p.in[31] + (size_t)l * 1048576; J.ldw = 1024; J.K = 1024; J.N = 1024; J.WT = mb + MO_WCO / 2 + (size_t)l * 1048576; J.ldwt = 1024; }
        else if (kind == 3) { J.W = p.in[32] + (size_t)l * 4194304; J.ldw = 4096; J.K = 1024; J.N = 4096; J.WT = mb + MO_WUP / 2 + (size_t)l * 4194304; J.ldwt = 1024; }
        else                { J.W = p.in[33] + (size_t)l * 4194304; J.ldw = 1024; J.K = 4096; J.N = 1024; J.WT = mb + MO_WDN / 2 + (size_t)l * 4194304; J.ldwt = 4096; }
    }
}
constexpr int N_TJOBS = 44;

__device__ __forceinline__ void transpose_item(const TJob& J, LAS float* scr, int item, int lane) {
    const int nblk = J.N / 32, kb = item / nblk, nb = item % nblk, k0 = 64 * kb, n0 = 32 * nb;
#pragma unroll 8
    for (int i = 0; i < 32; ++i) { const int kk = 2 * i + (lane >> 5);
        const float sc = J.mu ? (J.s0 + J.s1 * J.mu[k0 + kk]) : 1.f;
        scr[kk * 33 + (lane & 31)] = J.W[(size_t)(k0 + kk) * J.ldw + n0 + (lane & 31)] * sc; }
    asm volatile("s_waitcnt lgkmcnt(0)" ::: "memory");
    const int c = lane & 7;
#pragma unroll
    for (int j = 0; j < 4; ++j) { const int n = (lane >> 3) + 8 * j; const LAS float* s = scr + (8 * c) * 33 + n;
        u32x4 o; o.x = cvt_pk_bf16(s[0 * 33], s[1 * 33]); o.y = cvt_pk_bf16(s[2 * 33], s[3 * 33]); o.z = cvt_pk_bf16(s[4 * 33], s[5 * 33]); o.w = cvt_pk_bf16(s[6 * 33], s[7 * 33]);
        *(GAS u32x4*)(J.WT + (size_t)(J.row_off + n0 + n) * J.ldwt + J.col_off + k0 + 8 * c) = o; }
    asm volatile("s_waitcnt lgkmcnt(0)" ::: "memory");
}

__device__ __forceinline__ void norm_rows(const float* src, const float* g, bf16_t* dst, int nrows, int gw, int ngw, int lane) {
    f32x4 gv[4];
#pragma unroll
    for (int j = 0; j < 4; ++j) gv[j] = *(const GAS f32x4*)(g + 4 * lane + 256 * j);
    f32x4 v[4], vn[4];
    if (gw < nrows) { const GAS f32x4* xp = (const GAS f32x4*)(src + (size_t)gw * 1024) + lane;
#pragma unroll
        for (int j = 0; j < 4; ++j) v[j] = xp[64 * j]; }
    for (int r = gw; r < nrows; r += ngw) {
        if (r + ngw < nrows) { const GAS f32x4* xp = (const GAS f32x4*)(src + (size_t)(r + ngw) * 1024) + lane;
#pragma unroll
            for (int j = 0; j < 4; ++j) vn[j] = xp[64 * j]; }
        float ss = 0.f;
#pragma unroll
        for (int j = 0; j < 4; ++j) ss += dot4(v[j], v[j]);
        const float rs = rsqrtf(wave_sum(ss) * (1.f / 1024.f) + RMS_EPS);
        GAS u32x2* op = (GAS u32x2*)(dst + (size_t)r * 1024) + lane;
#pragma unroll
        for (int j = 0; j < 4; ++j) { op[64 * j] = pack4(v[j] * rs * gv[j]); v[j] = vn[j]; }
    }
}

__device__ __forceinline__ void prologue_phase(const Params& p, LAS unsigned char* lds, int gw, int ngw, int wave, int lane) {
    LAS float* scr = (LAS float*)(lds + wave * 16384);
    int base = 0;
    for (int j = 0; j < N_TJOBS; ++j) {
        TJob J; get_job(j, p, J);
        const int n = (J.K / 64) * (J.N / 32);
        int first = (gw - (base % ngw) + ngw) % ngw;
        for (int it = first; it < n; it += ngw) transpose_item(J, scr, it, lane);
        base += n;
    }
    bf16_t* mb = (bf16_t*)(p.ws + WS_MISC);
    { bf16_t* wl2 = mb + MO_WL2 / 2; const int gt = gw * 64 + lane, ngt = ngw * 64;
      for (int i = gt; i < 3072 * 32; i += ngt) { const int row = i >> 5, c8 = (i & 31) * 8, w = row >> 10;
          const bool nz = (w == 0) ? (c8 < 64) : (w == 1 ? (c8 >= 64 && c8 < 128) : (c8 >= 128));
          if (!nz) *(GAS u32x4*)(wl2 + (size_t)row * 256 + c8) = (u32x4){0u, 0u, 0u, 0u}; }
      float* sp = (float*)(p.ws + WS_MISC + MO_SP);
      for (int i = gt; i < 1024; i += ngt) { const float y = -p.in[10][i]; sp[i] = fmaxf(y, 0.f) + __logf(1.f + __expf(-fabsf(y))); } }
    norm_rows(p.in[1], p.in[3], mb + MO_MEMN / 2, 8192, gw, ngw, lane);
    norm_rows(p.in[0], p.in[2], (bf16_t*)(p.ws + 0 * SLOT), T_TOK, gw, ngw, lane);
}

template <int MODE, int XS, int XD>
__device__ __forceinline__ void resnorm_phase(const bf16_t* tb, const void* xsrc, void* xdst, const float* gpost, const float* gpre, bf16_t* xn, int gw, int ngw, int lane, int rend = T_TOK) {
    f32x4 gp[4], gq[4];
#pragma unroll
    for (int j = 0; j < 4; ++j) { gp[j] = *(const GAS f32x4*)(gpost + 4 * lane + 256 * j); gq[j] = MODE ? *(const GAS f32x4*)(gpre + 4 * lane + 256 * j) : (f32x4){0.f, 0.f, 0.f, 0.f}; }
    u32x2 tw[4], twn[4], xb[4], xbn[4]; f32x4 xf[4], xfn[4];
#define RN_LOAD(row, TW, XF, XB) do { const GAS u32x2* tp_ = (const GAS u32x2*)(tb + (size_t)(row) * 1024) + lane; \
        const GAS f32x4* xp_ = (const GAS f32x4*)((const float*)xsrc + (size_t)(row) * 1024) + lane; const GAS u32x2* xbp_ = (const GAS u32x2*)((const bf16_t*)xsrc + (size_t)(row) * 1024) + lane; \
        _Pragma("unroll") for (int j = 0; j < 4; ++j) { TW[j] = tp_[64 * j]; if (XS == 0) XF[j] = xp_[64 * j]; else XB[j] = xbp_[64 * j]; } } while (0)
    if (gw < rend) RN_LOAD(gw, tw, xf, xb);
    for (int r = gw; r < rend; r += ngw) {
        if (r + ngw < rend) RN_LOAD(r + ngw, twn, xfn, xbn);
        f32x4 xv[4], tv[4];
#pragma unroll
        for (int j = 0; j < 4; ++j) { if (XS == 0) xv[j] = xf[j]; else xv[j] = unpack4(xb[j]); }
        float ss = 0.f;
#pragma unroll
        for (int j = 0; j < 4; ++j) { tv[j] = unpack4(tw[j]); ss += dot4(tv[j], tv[j]); }
        const float rs = rsqrtf(wave_sum(ss) * (1.f / 1024.f) + RMS_EPS);
        float s2 = 0.f;
        GAS f32x4* op = (GAS f32x4*)((float*)xdst + (size_t)r * 1024) + lane;
        GAS u32x2* obp = (GAS u32x2*)((bf16_t*)xdst + (size_t)r * 1024) + lane;
#pragma unroll
        for (int j = 0; j < 4; ++j) { xv[j] = xv[j] + tv[j] * rs * gp[j]; s2 += dot4(xv[j], xv[j]); if (XD == 0) op[64 * j] = xv[j]; else obp[64 * j] = pack4(xv[j]); }
        if (MODE) {
            const float rs2 = rsqrtf(wave_sum(s2) * (1.f / 1024.f) + RMS_EPS);
            if (MODE == 1) {
                GAS u32x2* o = (GAS u32x2*)(xn + (size_t)r * 1024) + lane;
#pragma unroll
                for (int j = 0; j < 4; ++j) o[64 * j] = pack4(xv[j] * rs2 * gq[j]);
            } else {
                GAS u32x2* o = (GAS u32x2*)(xn + (size_t)r * 2048) + lane;
                const bool has_next = ((r + 1) & (SEQ - 1)) != 0, first = (r & (SEQ - 1)) == 0;
#pragma unroll
                for (int j = 0; j < 4; ++j) { const u32x2 w = pack4(xv[j] * rs2 * gq[j]); o[64 * j] = w;
                    if (has_next) o[512 + 256 + 64 * j] = w;
                    if (first) { u32x2 zz; asm volatile("v_mov_b32 %0, 0\n\tv_mov_b32 %1, 0" : "=v"(zz.x), "=v"(zz.y)); o[256 + 64 * j] = zz; } }
            }
        }
#pragma unroll
        for (int j = 0; j < 4; ++j) { tw[j] = twn[j]; xf[j] = xfn[j]; xb[j] = xbn[j]; }
    }
#undef RN_LOAD
}

__device__ __forceinline__ void resnorm_mix_phase(const bf16_t* tb, const bf16_t* xsrc, bf16_t* xdst, const float* gpost, const float* gpre, const float* mu,
                                                  bf16_t* XC, bf16_t* XR, bf16_t* XK, bf16_t* XV, int gw, int ngw, int lane, int base = 0, int count = T_TOK / 32) {
    f32x4 gp[4], gq[4], mr[4], mk[4], mv[4];
#pragma unroll
    for (int j = 0; j < 4; ++j) { const int c = 4 * lane + 256 * j; gp[j] = *(const GAS f32x4*)(gpost + c); gq[j] = *(const GAS f32x4*)(gpre + c);
        mr[j] = *(const GAS f32x4*)(mu + c); mk[j] = *(const GAS f32x4*)(mu + 2 * 1024 + c); mv[j] = *(const GAS f32x4*)(mu + 3 * 1024 + c); }
    for (int blk = base + gw; blk < base + count; blk += ngw) {
        const int r0 = blk * 32;
        f32x4 prev[4];
#pragma unroll
        for (int j = 0; j < 4; ++j) prev[j] = (f32x4){0.f, 0.f, 0.f, 0.f};
        const int rr0 = ((r0 & (SEQ - 1)) == 0 ? 0 : -1);
        u32x2 tw[4], xw[4], twn[4], xwn[4];
#define RM_LOAD(row, TW, XW) do { const GAS u32x2* tp_ = (const GAS u32x2*)(tb + (size_t)(row) * 1024) + lane; const GAS u32x2* xbp_ = (const GAS u32x2*)(xsrc + (size_t)(row) * 1024) + lane; \
            _Pragma("unroll") for (int j = 0; j < 4; ++j) { TW[j] = tp_[64 * j]; XW[j] = xbp_[64 * j]; } } while (0)
        RM_LOAD(r0 + rr0, tw, xw);
        for (int rr = rr0; rr < 32; ++rr) {
            const int r = r0 + rr;
            if (rr + 1 < 32) RM_LOAD(r + 1, twn, xwn);
            f32x4 xv[4], tv[4];
            float ss = 0.f;
#pragma unroll
            for (int j = 0; j < 4; ++j) { tv[j] = unpack4(tw[j]); xv[j] = unpack4(xw[j]); ss += dot4(tv[j], tv[j]); }
            const float rs = rsqrtf(wave_sum(ss) * (1.f / 1024.f) + RMS_EPS);
            float s2 = 0.f;
#pragma unroll
            for (int j = 0; j < 4; ++j) { xv[j] = xv[j] + tv[j] * rs * gp[j]; s2 += dot4(xv[j], xv[j]); }
            const float rs2 = rsqrtf(wave_sum(s2) * (1.f / 1024.f) + RMS_EPS);
            f32x4 xn[4];
#pragma unroll
            for (int j = 0; j < 4; ++j) xn[j] = xv[j] * rs2 * gq[j];
            if (rr >= 0) {
                GAS u32x2* ox = (GAS u32x2*)(xdst + (size_t)r * 1024) + lane;
                GAS u32x2* oc = (GAS u32x2*)(XC + (size_t)r * 2048) + lane;
                GAS u32x2* o1 = (GAS u32x2*)(XR + (size_t)r * 1024) + lane; GAS u32x2* o2 = (GAS u32x2*)(XK + (size_t)r * 1024) + lane; GAS u32x2* o3 = (GAS u32x2*)(XV + (size_t)r * 1024) + lane;
#pragma unroll
                for (int j = 0; j < 4; ++j) { const f32x4 xx = prev[j] - xn[j];
                    ox[64 * j] = pack4(xv[j]); oc[64 * j] = pack4(xn[j]); oc[256 + 64 * j] = pack4(prev[j]);
                    o1[64 * j] = pack4(xn[j] + xx * mr[j]); o2[64 * j] = pack4(xn[j] + xx * mk[j]); o3[64 * j] = pack4(xn[j] + xx * mv[j]); }
            }
#pragma unroll
            for (int j = 0; j < 4; ++j) { prev[j] = xn[j]; tw[j] = twn[j]; xw[j] = xwn[j]; }
        }
#undef RM_LOAD
    }
}

__device__ __forceinline__ void conv_phase(const bf16_t* U, const float* cw, const float* cb, bf16_t* C, int gw, int ngw, int lane, int base = 0, int count = NBATCH * 256) {
    const int half = gw & 1, ch0 = half * 512 + lane * 8;
    f32x4 w[4][2], bias[2];
#pragma unroll
    for (int tap = 0; tap < 4; ++tap) { w[tap][0] = *(const GAS f32x4*)(cw + tap * 1024 + ch0); w[tap][1] = *(const GAS f32x4*)(cw + tap * 1024 + ch0 + 4); }
    bias[0] = *(const GAS f32x4*)(cb + ch0); bias[1] = *(const GAS f32x4*)(cb + ch0 + 4);
    for (int k_ = gw >> 1; k_ < count; k_ += ngw >> 1) {
        const int it = base + k_; const int b = it >> 8, tb = it & 255, t0 = tb * 8; const size_t rowbase = (size_t)b * SEQ;
        f32x4 rows[11][2];
#pragma unroll
        for (int k = 0; k < 11; ++k) { const int t = t0 - 3 + k; u32x4 q = (u32x4){0u, 0u, 0u, 0u};
            if (t >= 0) q = *(const GAS u32x4*)(U + (rowbase + t) * 1024 + ch0);
            rows[k][0] = (f32x4){bf_lo(q.x), bf_hi(q.x), bf_lo(q.y), bf_hi(q.y)}; rows[k][1] = (f32x4){bf_lo(q.z), bf_hi(q.z), bf_lo(q.w), bf_hi(q.w)}; }
#pragma unroll
        for (int o = 0; o < 8; ++o) { f32x4 a0 = bias[0], a1 = bias[1];
#pragma unroll
            for (int tap = 0; tap < 4; ++tap) { a0 += rows[o + tap][0] * w[tap][0]; a1 += rows[o + tap][1] * w[tap][1]; }
            *(GAS u32x4*)(C + (rowbase + t0 + o) * 1024 + ch0) = pack8(a0, a1); }
    }
}

__device__ __forceinline__ void lru_scan_a(const bf16_t* LA, const bf16_t* BV, float* SUMP, float* SUMH, int gw, int ngw, int lane, int base = 0, int count = 2048) {
    for (int it = base + gw; it < base + count; it += ngw) {
        const int b = it >> 6, chunk = (it >> 1) & 31, half = it & 1, ch0 = half * 512 + lane * 8;
        const size_t row0 = (size_t)b * SEQ + chunk * 64;
        float h[8], sl[8];
#pragma unroll
        for (int e = 0; e < 8; ++e) { h[e] = 0.f; sl[e] = 0.f; }
        for (int s0 = 0; s0 < 64; s0 += 8) {
            u32x4 lq[8], bq[8];
#pragma unroll
            for (int s = 0; s < 8; ++s) { lq[s] = *(const GAS u32x4*)(LA + (row0 + s0 + s) * 1024 + ch0); bq[s] = *(const GAS u32x4*)(BV + (row0 + s0 + s) * 1024 + ch0); }
#pragma unroll
            for (int s = 0; s < 8; ++s) {
                const float l[8] = {bf_lo(lq[s].x), bf_hi(lq[s].x), bf_lo(lq[s].y), bf_hi(lq[s].y), bf_lo(lq[s].z), bf_hi(lq[s].z), bf_lo(lq[s].w), bf_hi(lq[s].w)};
                const float bb[8] = {bf_lo(bq[s].x), bf_hi(bq[s].x), bf_lo(bq[s].y), bf_hi(bq[s].y), bf_lo(bq[s].z), bf_hi(bq[s].z), bf_lo(bq[s].w), bf_hi(bq[s].w)};
#pragma unroll
                for (int e = 0; e < 8; ++e) { sl[e] += l[e]; h[e] = __expf(l[e]) * h[e] + bb[e]; }
            }
        }
        const size_t so = (size_t)(b * 32 + chunk) * 1024 + ch0;
        *(GAS f32x4*)(SUMP + so) = (f32x4){__expf(sl[0]), __expf(sl[1]), __expf(sl[2]), __expf(sl[3])}; *(GAS f32x4*)(SUMP + so + 4) = (f32x4){__expf(sl[4]), __expf(sl[5]), __expf(sl[6]), __expf(sl[7])};
        *(GAS f32x4*)(SUMH + so) = (f32x4){h[0], h[1], h[2], h[3]}; *(GAS f32x4*)(SUMH + so + 4) = (f32x4){h[4], h[5], h[6], h[7]};
    }
}
__device__ __forceinline__ void lru_scan_b(const bf16_t* LA, const bf16_t* BV, const bf16_t* Y, const float* SUMP, const float* SUMH, bf16_t* HY, int gw, int ngw, int lane, int base = 0, int count = 2048) {
    for (int it = base + gw; it < base + count; it += ngw) {
        const int b = it >> 6, chunk = (it >> 1) & 31, half = it & 1, ch0 = half * 512 + lane * 8;
        const size_t row0 = (size_t)b * SEQ + chunk * 64;
        float h[8];
#pragma unroll
        for (int e = 0; e < 8; ++e) h[e] = 0.f;
        for (int c = 0; c < chunk; ++c) {
            const size_t so = (size_t)(b * 32 + c) * 1024 + ch0;
            const f32x4 p0 = *(const GAS f32x4*)(SUMP + so), p1 = *(const GAS f32x4*)(SUMP + so + 4), h0 = *(const GAS f32x4*)(SUMH + so), h1 = *(const GAS f32x4*)(SUMH + so + 4);
#pragma unroll
            for (int e = 0; e < 4; ++e) { h[e] = p0[e] * h[e] + h0[e]; h[4 + e] = p1[e] * h[4 + e] + h1[e]; }
        }
        for (int s0 = 0; s0 < 64; s0 += 8) {
            u32x4 lq[8], bq[8], yq[8];
#pragma unroll
            for (int s = 0; s < 8; ++s) { lq[s] = *(const GAS u32x4*)(LA + (row0 + s0 + s) * 1024 + ch0); bq[s] = *(const GAS u32x4*)(BV + (row0 + s0 + s) * 1024 + ch0); yq[s] = *(const GAS u32x4*)(Y + (row0 + s0 + s) * 1024 + ch0); }
#pragma unroll
            for (int s = 0; s < 8; ++s) {
                const float l[8] = {bf_lo(lq[s].x), bf_hi(lq[s].x), bf_lo(lq[s].y), bf_hi(lq[s].y), bf_lo(lq[s].z), bf_hi(lq[s].z), bf_lo(lq[s].w), bf_hi(lq[s].w)};
                const float bb[8] = {bf_lo(bq[s].x), bf_hi(bq[s].x), bf_lo(bq[s].y), bf_hi(bq[s].y), bf_lo(bq[s].z), bf_hi(bq[s].z), bf_lo(bq[s].w), bf_hi(bq[s].w)};
                const float yy[8] = {bf_lo(yq[s].x), bf_hi(yq[s].x), bf_lo(yq[s].y), bf_hi(yq[s].y), bf_lo(yq[s].z), bf_hi(yq[s].z), bf_lo(yq[s].w), bf_hi(yq[s].w)};
                float o[8];
#pragma unroll
                for (int e = 0; e < 8; ++e) { h[e] = __expf(l[e]) * h[e] + bb[e]; o[e] = h[e] * yy[e]; }
                u32x4 w; w.x = cvt_pk_bf16(o[0], o[1]); w.y = cvt_pk_bf16(o[2], o[3]); w.z = cvt_pk_bf16(o[4], o[5]); w.w = cvt_pk_bf16(o[6], o[7]);
                *(GAS u32x4*)(HY + (row0 + s0 + s) * 1024 + ch0) = w;
            }
        }
    }
}

constexpr int RW_TC = 16;
#define RW_BAR() do { asm volatile("s_waitcnt lgkmcnt(0)" ::: "memory"); __builtin_amdgcn_s_barrier(); asm volatile("" ::: "memory"); } while (0)
typedef float f32x16 __attribute__((ext_vector_type(16)));
typedef __bf16 bf16x2_t __attribute__((ext_vector_type(2)));
__device__ __forceinline__ unsigned cvtpk_c(float lo, float hi) { f32x2 v = {lo, hi}; bf16x2_t b = __builtin_convertvector(v, bf16x2_t); return __builtin_bit_cast(unsigned, b); }
#define RW_MFMA(a, b, c) __builtin_amdgcn_mfma_f32_32x32x16_bf16((a), (b), (c), 0, 0, 0)
template <int SS> __device__ __forceinline__ bf16x8 rw_pack(const f32x16& x) {
    u32x4 p; p.x = cvtpk_c(x[8 * SS], x[8 * SS + 1]); p.y = cvtpk_c(x[8 * SS + 2], x[8 * SS + 3]); p.z = cvtpk_c(x[8 * SS + 4], x[8 * SS + 5]); p.w = cvtpk_c(x[8 * SS + 6], x[8 * SS + 7]);
    return __builtin_bit_cast(bf16x8, p);
}
constexpr int RW_IMG = 0, RW_BK = 4352, RW_VF = 8448, RW_CL = 12544, RW_BLK = 12800;
constexpr int RW_YB = 4 * RW_BLK, RW_FB = RW_YB + 16384, RW_TBL = RW_FB + 26112;
__device__ __forceinline__ f32x16 rw_round(const f32x16 (&XT)[2], const LAS unsigned char* img) {
    f32x16 Y;
#pragma unroll
    for (int q = 0; q < 16; ++q) Y[q] = 0.f;
    Y = RW_MFMA(*(const LAS bf16x8*)(img + 0),   rw_pack<0>(XT[0]), Y);
    Y = RW_MFMA(*(const LAS bf16x8*)(img + 64),  rw_pack<1>(XT[0]), Y);
    Y = RW_MFMA(*(const LAS bf16x8*)(img + 128), rw_pack<0>(XT[1]), Y);
    Y = RW_MFMA(*(const LAS bf16x8*)(img + 192), rw_pack<1>(XT[1]), Y);
    return Y;
}
struct RwOp { bf16x8 f0, f1, f2, f3; unsigned bk0, bk1; float vi; };
#define RW_DSR128(dst, addr, off) asm volatile("ds_read_b128 %0, %1 offset:%2" : "=v"(dst) : "v"(addr), "i"(off) : "memory")
#define RW_DSR32(dst, addr, off) asm volatile("ds_read_b32 %0, %1 offset:%2" : "=v"(dst) : "v"(addr), "i"(off) : "memory")
template <int T> __device__ __forceinline__ void rw_opissue(RwOp& o, unsigned img_a, unsigned bk_a, unsigned vf_a) {
    RW_DSR32(o.bk0, bk_a, T * 256); RW_DSR32(o.bk1, bk_a, T * 256 + 128); RW_DSR32(o.vi, vf_a, T * 256);
    RW_DSR128(o.f0, img_a, (T + 1) * 256); RW_DSR128(o.f1, img_a, (T + 1) * 256 + 64); RW_DSR128(o.f2, img_a, (T + 1) * 256 + 128); RW_DSR128(o.f3, img_a, (T + 1) * 256 + 192);
}
__device__ __forceinline__ void rw_opwait(RwOp& o) {
    asm volatile("s_waitcnt lgkmcnt(0)" : "+v"(o.f0), "+v"(o.f1), "+v"(o.f2), "+v"(o.f3), "+v"(o.bk0), "+v"(o.bk1), "+v"(o.vi) :: "memory");
}
template <int T> __device__ __forceinline__ void rw_step(f32x16 (&XT)[2], float& sa, RwOp& cur, unsigned img_a, unsigned bk_a, unsigned vf_a, int hl, LAS float* yrow) {
    rw_opwait(cur);
    RwOp nxt;
    if constexpr (T + 1 < RW_TC) rw_opissue<T + 1>(nxt, img_a, bk_a, vf_a);
    const u32x4 b3 = (u32x4){cvtpk_c(sa, cur.vi), 0u, 0u, 0u};
    const u32x4 a30 = (u32x4){hl ? 0u : cur.bk0, 0u, 0u, 0u}, a31 = (u32x4){hl ? 0u : cur.bk1, 0u, 0u, 0u};
    XT[0] = RW_MFMA(__builtin_bit_cast(bf16x8, a30), __builtin_bit_cast(bf16x8, b3), XT[0]);
    XT[1] = RW_MFMA(__builtin_bit_cast(bf16x8, a31), __builtin_bit_cast(bf16x8, b3), XT[1]);
    f32x16 Y;
#pragma unroll
    for (int q = 0; q < 16; ++q) Y[q] = 0.f;
    Y = RW_MFMA(cur.f0, rw_pack<0>(XT[0]), Y);
    Y = RW_MFMA(cur.f1, rw_pack<1>(XT[0]), Y);
    Y = RW_MFMA(cur.f2, rw_pack<0>(XT[1]), Y);
    Y = RW_MFMA(cur.f3, rw_pack<1>(XT[1]), Y);
    sa = Y[1];
    if (hl == 0) yrow[T * 64] = Y[0];
    if constexpr (T + 1 < RW_TC) rw_step<T + 1>(XT, sa, nxt, img_a, bk_a, vf_a, hl, yrow);
}
__device__ __forceinline__ void rwkv_stage(LAS unsigned char* blk, LAS float* fb, int st, int cq, u32x2 rr, u32x2 kr, u32x2 vr, u32x2 ar, u32x2 wcur, u32x2 wprv, const LAS float* cst) {
    asm volatile("" : "+v"(st), "+v"(cq));
    const f32x4 kk4 = *(const LAS f32x4*)(cst + cq * 4), ka4 = *(const LAS f32x4*)(cst + 64 + cq * 4), rk4 = *(const LAS f32x4*)(cst + 128 + cq * 4);
    const f32x4 r = unpack4(rr), k = unpack4(kr), v = unpack4(vr), a = unpack4(ar);
    const f32x4 incl = unpack4(wcur);
    f32x4 before = unpack4(wprv);
    if (st == 0) before = (f32x4){0.f, 0.f, 0.f, 0.f};
    f32x4 cprev, ct, ict;
#pragma unroll
    for (int e = 0; e < 4; ++e) { cprev[e] = __expf(-before[e]); ct[e] = __expf(-incl[e]); ict[e] = __expf(incl[e]); }
    const f32x4 kkr = k * kk4;
    const float ss = sum16(dot4(kkr, kkr));
    const float inv = 1.0f / fmaxf(sqrtf(ss), 1e-12f);
    const f32x4 kkn = kkr * inv;
    const f32x4 kp = k * (1.0f + (a - 1.0f) * ka4);
    const float bonus = sum16(dot4(r * kp, rk4));
    const f32x4 at = -kkn * cprev, rt = r * ct, bt = kkn * a * ict, kt = kp * ict;
    const int jb = cq >> 3, cl3 = cq & 7, s_ = cl3 >> 2, g_ = (cl3 >> 1) & 1, h_ = cl3 & 1;
    const int ioff = (jb * 2 + s_) * 64 + h_ * 32 + g_ * 8;
    *(LAS u32x2*)(blk + RW_IMG + (st + 1) * 256 + ioff) = pack4(rt);
    *(LAS u32x2*)(blk + RW_IMG + st * 256 + ioff + 16) = pack4(at);
    if (st == 15) *(LAS u32x2*)(blk + RW_IMG + 16 * 256 + ioff + 16) = (u32x2){0u, 0u};
    if (st == 0) *(LAS u32x2*)(blk + RW_IMG + ioff) = (u32x2){0u, 0u};
    u32x4 bkw; bkw.x = cvt_pk_bf16(bt.x, kt.x); bkw.y = cvt_pk_bf16(bt.y, kt.y); bkw.z = cvt_pk_bf16(bt.z, kt.z); bkw.w = cvt_pk_bf16(bt.w, kt.w);
    *(LAS u32x4*)(blk + RW_BK + st * 256 + cq * 16) = bkw;
    *(LAS f32x4*)(blk + RW_VF + st * 256 + cq * 16) = v;
    if (st == 15) *(LAS f32x4*)(blk + RW_CL + cq * 16) = ct;
    *(LAS f32x4*)(fb + st * 68 + cq * 4) = v;
    if (cq == 0) fb[st * 68 + 64] = bonus;
}
__device__ __forceinline__ void rwkv_scan_phase(LAS unsigned char* lds, const bf16_t* R, const bf16_t* Kb, const bf16_t* V, const bf16_t* W, const bf16_t* A, const bf16_t* G, bf16_t* Z,
                                                const float* k_k, const float* k_a, const float* r_k, const float* gn_g, const float* gn_b, int wave) {
    constexpr int TC = RW_TC, NCH = SEQ / TC;
    LAS float* ybuf = (LAS float*)(lds + RW_YB);
    LAS float* fbuf = (LAS float*)(lds + RW_FB);
    LAS int* tbl = (LAS int*)(lds + RW_TBL);
    const int lane = lane_opaque();
    int role = (wave < 4) ? wave : -1, hidx = (wave < 4) ? 0 : wave - 4;
    {
        const int simd = (int)(__builtin_amdgcn_s_getreg(4 | (4 << 6) | (1 << 11)) & 3u);
        if (lane == 0) tbl[wave] = simd;
        __syncthreads();
        int first[4] = {-1, -1, -1, -1};
#pragma unroll
        for (int w = 7; w >= 0; --w) { const int sd = tbl[w];
#pragma unroll
            for (int q = 0; q < 4; ++q) if (sd == q) first[q] = w; }
        if (first[0] >= 0 && first[1] >= 0 && first[2] >= 0 && first[3] >= 0) {
            role = -1; hidx = 0;
#pragma unroll
            for (int q = 0; q < 4; ++q) if (first[q] == wave) role = q;
#pragma unroll
            for (int w = 0; w < 8; ++w) { const bool isc = (first[0] == w) || (first[1] == w) || (first[2] == w) || (first[3] == w); if (w < wave && !isc) ++hidx; }
        }
        role = __builtin_amdgcn_readfirstlane(role); hidx = __builtin_amdgcn_readfirstlane(hidx) & 3;
        __syncthreads();
    }
    const bool comp = role >= 0; const int hc = (role >> 1) & 1, ib = role & 1, r32 = lane & 31, hl = lane >> 5;
    const int ht = hidx * 64 + lane, st = ht >> 4, cq = ht & 15;
    for (int pp = blockIdx.x; pp < 256; pp += gridDim.x) {
        const int pair = (4 * (pp & 7) + (pp >> 6)) * 8 + ((pp >> 3) & 7);
        if (comp) {
            f32x16 XT[2];
#pragma unroll
            for (int q = 0; q < 16; ++q) { XT[0][q] = 0.f; XT[1][q] = 0.f; }
            RW_BAR();
            for (int c = 0; c < NCH; ++c) {
                const LAS unsigned char* blk = lds + (hc * 2 + (c & 1)) * RW_BLK;
                const unsigned img_a = (unsigned)(size_t)(blk + RW_IMG + hl * 32 + (r32 & 1) * 16), bk_a = (unsigned)(size_t)(blk + RW_BK + r32 * 4), vf_a = (unsigned)(size_t)(blk + RW_VF + (ib * 32 + r32) * 4);
                LAS float* yrow = ybuf + (((c & 1) * 2 + hc) * TC) * 64 + ib * 32 + r32;
                RwOp op0; rw_opissue<0>(op0, img_a, bk_a, vf_a);
                float sa;
                { const f32x16 Y = rw_round(XT, blk + RW_IMG + hl * 32 + (r32 & 1) * 16); sa = Y[1]; }
                rw_step<0>(XT, sa, op0, img_a, bk_a, vf_a, hl, yrow);
#pragma unroll
                for (int q = 0; q < 16; ++q) { const int jr = (q & 3) + 8 * (q >> 2) + 4 * hl;
                    XT[0][q] *= *(const LAS float*)(blk + RW_CL + jr * 4); XT[1][q] *= *(const LAS float*)(blk + RW_CL + (32 + jr) * 4); }
                RW_BAR();
            }
            RW_BAR();
        } else {
            int col[2]; size_t rowbase[2];
            LAS float* cst = (LAS float*)(lds + RW_TBL + 64);
#pragma unroll
            for (int hh = 0; hh < 2; ++hh) { const int chain = pair * 2 + hh; col[hh] = (chain & 15) * 64 + cq * 4; rowbase[hh] = (size_t)(chain >> 4) * SEQ;
                if ((lane >> 4) == 0) { LAS float* c5 = cst + hh * 320 + cq * 4;
                    *(LAS f32x4*)(c5) = *(const GAS f32x4*)(k_k + col[hh]); *(LAS f32x4*)(c5 + 64) = *(const GAS f32x4*)(k_a + col[hh]); *(LAS f32x4*)(c5 + 128) = *(const GAS f32x4*)(r_k + col[hh]);
                    *(LAS f32x4*)(c5 + 192) = *(const GAS f32x4*)(gn_g + col[hh]); *(LAS f32x4*)(c5 + 256) = *(const GAS f32x4*)(gn_b + col[hh]); } }
            asm volatile("s_waitcnt lgkmcnt(0)" ::: "memory");
            u32x2 rr[2], kr[2], vr[2], ar[2], gr[2], wown[2], wprv[2];
#define RW_EOFF(hh, row) ({ int st_ = st, cq_ = cq; asm volatile("" : "+v"(st_), "+v"(cq_)); (size_t)(((pair * 2 + (hh)) >> 4) * SEQ + (row) + st_) * 1024 + (size_t)((((pair * 2 + (hh)) & 15) * 64) + cq_ * 4); })
#define RW_LOADS(chunk) do { _Pragma("unroll") for (int hh = 0; hh < 2; ++hh) { size_t o = RW_EOFF(hh, (chunk) * TC); asm volatile("" : "+v"(o));   \
                rr[hh] = *(const GAS u32x2*)(R + o); kr[hh] = *(const GAS u32x2*)(Kb + o); vr[hh] = *(const GAS u32x2*)(V + o); ar[hh] = *(const GAS u32x2*)(A + o); \
                wown[hh] = *(const GAS u32x2*)(W + o); wprv[hh] = *(const GAS u32x2*)(W + (st > 0 ? o - 1024 : o)); } } while (0)
#define RW_STAGE(chunk, f3) do { _Pragma("unroll") for (int hh = 0; hh < 2; ++hh) \
                rwkv_stage(lds + (hh * 2 + ((chunk) & 1)) * RW_BLK, fbuf + ((f3) * 2 + hh) * TC * 68, st, cq, rr[hh], kr[hh], vr[hh], ar[hh], wown[hh], wprv[hh], cst + hh * 320); } while (0)
            RW_LOADS(0);
            RW_STAGE(0, 0);
            RW_LOADS(1);
#pragma unroll
            for (int hh = 0; hh < 2; ++hh) gr[hh] = *(const GAS u32x2*)(G + RW_EOFF(hh, 0));
            RW_BAR();
            int c3 = 0;
            for (int c = 0; c <= NCH; ++c) {
                const int p3 = (c3 == 0) ? 2 : c3 - 1, n3 = (c3 == 2) ? 0 : c3 + 1;
                if (c >= 1) {
#pragma unroll
                    for (int hh = 0; hh < 2; ++hh) {
                        const f32x4 y4 = *(const LAS f32x4*)(ybuf + ((((c - 1) & 1) * 2 + hh) * TC + st) * 64 + cq * 4);
                        const LAS float* fb = fbuf + ((p3 * 2 + hh) * TC + st) * 68;
                        const f32x4 v4 = *(const LAS f32x4*)(fb + cq * 4); const float bonus = fb[64];
                        const float mean = sum16((y4.x + y4.y) + (y4.z + y4.w)) * (1.f / 64.f);
                        const f32x4 d = y4 - mean;
                        const float var = sum16(dot4(d, d)) * (1.f / 64.f);
                        const f32x4 yn = d * rsqrtf(var + 64e-5f) * *(const LAS f32x4*)(cst + hh * 320 + 192 + cq * 4) + *(const LAS f32x4*)(cst + hh * 320 + 256 + cq * 4);
                        const f32x4 o = (yn + v4 * bonus) * unpack4(gr[hh]);
                        *(GAS u32x2*)(Z + RW_EOFF(hh, (c - 1) * TC)) = pack4(o);
                    }
                }
                if (c < NCH) {
#pragma unroll
                    for (int hh = 0; hh < 2; ++hh) gr[hh] = *(const GAS u32x2*)(G + RW_EOFF(hh, c * TC));
                }
                if (c + 1 < NCH) RW_STAGE(c + 1, n3);
                if (c + 2 < NCH) RW_LOADS(c + 2);
                RW_BAR();
                c3 = n3;
            }
#undef RW_LOADS
#undef RW_EOFF
#undef RW_STAGE
        }
    }
}

constexpr size_t MO_CTL = 121 * MiB;
#define GSYNC() do { ++nbar; grid_bar(ctr, nbar * gridDim.x, wave); } while (0)
#define XSYNC() do { if (gridDim.x == 256) { ++nxbar; grid_bar(ctr + 64 * (1 + (blockIdx.x & 7)), nxbar * 32u, wave); } else GSYNC(); } while (0)
#define XPAN ((int)(32 * (blockIdx.x & 7) + (blockIdx.x >> 3)))
#define XGW ((int)((32 * (blockIdx.x & 7) + (blockIdx.x >> 3)) * 256 + wave))
#define XEND ((int)((32 * (blockIdx.x & 7) + (blockIdx.x >> 3)) * 256 + 256))
#define LSYNC() do { asm volatile("s_waitcnt vmcnt(0) lgkmcnt(0)" ::: "memory"); __builtin_amdgcn_s_barrier(); __builtin_amdgcn_fence(__ATOMIC_ACQUIRE, "agent"); \
        asm volatile("s_waitcnt vmcnt(0)" ::: "memory"); __builtin_amdgcn_s_barrier(); asm volatile("" ::: "memory"); } while (0)
#define PGW ((int)(blockIdx.x * 256 + wave))
#define PEND ((int)(blockIdx.x * 256 + 256))
#ifndef DUPMASK
#define DUPMASK 0
#endif
#define NREP(g) (1 + ((DUPMASK >> (g)) & 1))
#define RLAST(g) (rep_ == NREP(g) - 1)
#define PH(g, ...) _Pragma("unroll 1") for (int rep_ = 0; rep_ < NREP(g); ++rep_) { __VA_ARGS__; GSYNC(); }
template <class E>
__device__ __forceinline__ void run_gemm(LAS unsigned char* lds, const bf16_t* A, const bf16_t* B, int lda, int ldb, int K, int nM, int nN, int acol_on, int acol_shift, int bbatch, int cshift, const E& e, int wave) {
    pg8::Gemm g{A, B, lda, ldb, K, acol_on, acol_shift, bbatch};
    int G_ = (int)gridDim.x; asm volatile("" : "+s"(G_));
    pg8::Order S; if (cshift < 0) S.init(nM, nN, G_, (int)blockIdx.x, (nM == G_) ? 1 : 0); else S.init(nM, nN, G_, (int)((blockIdx.x + cshift) % G_));
    pg8::gemm_phase<E, true>(lds, g, S, e, wave);
}
__device__ __forceinline__ unsigned char* opqp(unsigned char* q) { asm volatile("" : "+s"(q)); return q; }
__device__ __forceinline__ int opqi(int i) { asm volatile("" : "+s"(i)); return i; }
#define SLOTP(i) ((bf16_t*)(opqp(p.ws) + (size_t)(i) * SLOT))
#define MBP(off) ((bf16_t*)(opqp(p.ws) + WS_MISC + (off)))
#define PIN(i) (p.in[opqi(i)])
#define XRES ((float*)opqp((unsigned char*)p.out))
#define GAINS PIN(2)
#define XRES2 ((void*)(opqp((unsigned char*)p.out) + SLOT))
#define GW opqi((int)(blockIdx.x * 8 + wave))
#define NGW opqi((int)(gridDim.x * 8))

__global__ void __launch_bounds__(512, 2) fwd_megakernel(Params p) {
    extern __shared__ __attribute__((aligned(16))) unsigned char lds_raw[];
    LAS unsigned char* lds = (LAS unsigned char*)lds_raw;
    const int wave = __builtin_amdgcn_readfirstlane(threadIdx.x >> 6);
    unsigned* ctr = (unsigned*)(p.ws + WS_MISC + MO_CTL);
    unsigned nbar = 0, nxbar = 0;

    prologue_phase(p, lds, GW, NGW, wave, lane_opaque()); cg::this_grid().sync();

    { pg8::Epi<FWin> e{{SLOTP(1), SLOTP(2), PIN(7)}}; run_gemm(lds, SLOTP(0), MBP(MO_WIN), 1024, 1024, 1024, 256, 8, 0, 0, 0, 0, e, wave); }
    { pg8::Epi<FTile> e{{MBP(MO_KMEM), 4, 1}}; run_gemm(lds, MBP(MO_MEMN), MBP(MO_WKV), 1024, 1024, 1024, 32, 4, 0, 0, 0, 0, e, wave); }
    { pg8::Epi<FTile> e{{MBP(MO_VTMEM), 1, 4}}; run_gemm(lds, MBP(MO_WKV) + 1048576, MBP(MO_MEMN), 1024, 1024, 1024, 4, 32, 0, 0, 0, 128, e, wave); }
    XSYNC();
    conv_phase(SLOTP(2), PIN(4), PIN(5), SLOTP(3), wave, 8, lane_opaque(), XPAN * 32, 32);
    XSYNC();
    { EpiGate e{SLOTP(3), PIN(9), (const float*)MBP(MO_SP), SLOTP(4), SLOTP(5)}; run_gemm(lds, SLOTP(3), MBP(MO_WGATE), 1024, 256, 256, 256, 8, 1, 1, 0, 0, e, wave); }
    XSYNC();
    lru_scan_a(SLOTP(4), SLOTP(5), (float*)SLOTP(6), (float*)SLOTP(6) + 1048576, wave, 8, lane_opaque(), XPAN * 8, 8);
    XSYNC();
    lru_scan_b(SLOTP(4), SLOTP(5), SLOTP(1), (const float*)SLOTP(6), (const float*)SLOTP(6) + 1048576, SLOTP(0), wave, 8, lane_opaque(), XPAN * 8, 8);
    XSYNC();
    { pg8::Epi<FStd<0>> e{{SLOTP(1), 1024, PIN(12), 1.f}}; run_gemm(lds, SLOTP(0), MBP(MO_WOUT), 1024, 1024, 1024, 256, 4, 0, 0, 0, 0, e, wave); }
    XSYNC();
    resnorm_phase<1, 0, 1>(SLOTP(1), PIN(0), XRES, GAINS + 1 * 1024, GAINS + 2 * 1024, SLOTP(0), XGW, 8, lane_opaque(), XEND); GSYNC();

#pragma unroll 1
    for (int l = 0; l < 2; ++l) {
        if (l == 1) {
            { pg8::Epi<FStd<0>> e{{SLOTP(1), 1024, nullptr, 1.f}}; run_gemm(lds, SLOTP(0), MBP(MO_WRKV), 1024, 1024, 1024, 256, 4, 0, 0, 0, 0, e, wave); }
            { pg8::Epi<FStd<0>> e{{SLOTP(6), 1024, nullptr, 1.f}}; run_gemm(lds, SLOTP(2), MBP(MO_WRKV) + 1048576, 1024, 1024, 1024, 256, 4, 0, 0, 0, 0, e, wave); }
            XSYNC();
            { pg8::Epi<FStd<0>> e{{SLOTP(0), 1024, nullptr, 1.f}}; run_gemm(lds, SLOTP(3), MBP(MO_WRKV) + 2097152, 1024, 1024, 1024, 256, 4, 0, 0, 0, 0, e, wave); }
            { pg8::Epi<FLora> e{{SLOTP(2)}}; run_gemm(lds, SLOTP(4), MBP(MO_WRKV + 6 * MiB), 2048, 2048, 2048, 256, 1, 0, 0, 0, 0, e, wave); }
            GSYNC();
            { pg8::Epi<FL2> e{{opqp(p.ws), PIN(15), PIN(18)}}; run_gemm(lds, SLOTP(2), MBP(MO_WL2), 1024, 256, 256, 256, 12, 0, 0, 0, 0, e, wave); }
            XSYNC();
            rwkv_scan_phase(lds, SLOTP(1), SLOTP(6), SLOTP(0), SLOTP(3), SLOTP(4), SLOTP(5), SLOTP(1), PIN(23), PIN(24), PIN(25), PIN(26), PIN(27), wave);
            XSYNC();
            { pg8::Epi<FStd<0>> e{{SLOTP(2), 1024, nullptr, 1.f}}; run_gemm(lds, SLOTP(1), MBP(MO_WBO), 1024, 1024, 1024, 256, 4, 0, 0, 0, 0, e, wave); }
            { pg8::Epi<FTile> e{{MBP(MO_KMEM), 4, 1}}; run_gemm(lds, MBP(MO_MEMN), MBP(MO_WKV) + (size_t)1 * 2097152, 1024, 1024, 1024, 32, 4, 0, 0, 0, 0, e, wave); }
            { pg8::Epi<FTile> e{{MBP(MO_VTMEM), 1, 4}}; run_gemm(lds, MBP(MO_WKV) + (size_t)1 * 2097152 + 1048576, MBP(MO_MEMN), 1024, 1024, 1024, 4, 32, 0, 0, 0, 128, e, wave); }
            XSYNC();
            resnorm_phase<1, 1, 1>(SLOTP(2), XRES2, XRES2, GAINS + (6 + 1) * 1024, GAINS + (6 + 2) * 1024, SLOTP(0), XGW, 8, lane_opaque(), XEND); GSYNC();
        }
        const float* gl = GAINS + l * 6 * 1024;
        { pg8::Epi<FStd<0>> e{{SLOTP(1), 1024, nullptr, 0.0625f}}; run_gemm(lds, SLOTP(0), MBP(MO_WQ) + (size_t)l * 1048576, 1024, 1024, 1024, 256, 4, 0, 0, 0, 0, e, wave); }
        { EpiSoftmax e{(bf16_t*)(l == 0 ? XRES2 : (void*)XRES)}; run_gemm(lds, SLOTP(1), MBP(MO_KMEM), 1024, 256, 256, 256, 4, 1, 0, 4, 0, e, wave); }
        { pg8::Epi<FStd<0>> e{{SLOTP(1), 1024, nullptr, 1.f}}; run_gemm(lds, (const bf16_t*)(l == 0 ? XRES2 : (void*)XRES), MBP(MO_VTMEM), 1024, 256, 256, 256, 4, 1, 0, 4, 0, e, wave); }
        XSYNC();
        { pg8::Epi<FStd<0>> e{{SLOTP(0), 1024, nullptr, 1.f}}; run_gemm(lds, SLOTP(1), MBP(MO_WCO) + (size_t)l * 1048576, 1024, 1024, 1024, 256, 4, 0, 0, 0, 0, e, wave); }
        XSYNC();
        resnorm_phase<1, 1, 1>(SLOTP(0), l == 0 ? (void*)XRES : (void*)XRES2, l == 0 ? (void*)XRES : (void*)SLOTP(6), gl + 3 * 1024, gl + 4 * 1024, SLOTP(1), XGW, 8, lane_opaque(), XEND);
        XSYNC();
        { pg8::Epi<FStd<1>> e{{SLOTP(2), 4096, nullptr, 1.f}}; run_gemm(lds, SLOTP(1), MBP(MO_WUP) + (size_t)l * 4194304, 1024, 1024, 1024, 256, 16, 0, 0, 0, 0, e, wave); }
        XSYNC();
        { pg8::Epi<FStd<0>> e{{SLOTP(1), 1024, nullptr, 1.f}}; run_gemm(lds, SLOTP(2), MBP(MO_WDN) + (size_t)l * 4194304, 4096, 4096, 4096, 256, 4, 0, 0, 0, 0, e, wave); }
        if (l == 0) { GSYNC();     resnorm_mix_phase(SLOTP(1), (const bf16_t*)XRES, (bf16_t*)XRES2, gl + 5 * 1024, GAINS + 6 * 1024, PIN(13), SLOTP(4), SLOTP(0), SLOTP(2), SLOTP(3), wave, 8, lane_opaque(), XPAN * 8, 8); XSYNC(); }
        else        { GSYNC();     resnorm_phase<0, 1, 0>(SLOTP(1), SLOTP(6), XRES, gl + 5 * 1024, nullptr, nullptr, XGW, 8, lane_opaque(), XEND); }
    }
}

extern "C" void kernel_launch(void* const* d_in, const int* in_sizes, int n_in, void* d_out, int out_size, void* d_ws, size_t ws_size, hipStream_t stream) {
    static int grid_blocks = 0;
    if (grid_blocks == 0) {
        if (n_in != 34 || out_size != T_TOK * DM || ws_size < WS_NEED) { fprintf(stderr, "kernel_launch: unexpected problem (n_in %d out %d ws %zu need %zu)\n", n_in, out_size, ws_size, (size_t)WS_NEED); grid_blocks = -1; return; }
        int dev = 0, cus = 0, per_cu = 0;
        (void)hipGetDevice(&dev);
        (void)hipDeviceGetAttribute(&cus, hipDeviceAttributeMultiprocessorCount, dev);
        if (hipFuncSetAttribute((const void*)fwd_megakernel, hipFuncAttributeMaxDynamicSharedMemorySize, LDS_BYTES) != hipSuccess) { fprintf(stderr, "kernel_launch: hipFuncSetAttribute failed\n"); grid_blocks = -1; return; }
        (void)hipOccupancyMaxActiveBlocksPerMultiprocessor(&per_cu, (const void*)fwd_megakernel, 512, LDS_BYTES);
        if (per_cu < 1) per_cu = 1;
        grid_blocks = cus * per_cu;
        if (grid_blocks > 256) grid_blocks = 256;
    }
    if (grid_blocks < 0) return;
    (void)hipMemsetAsync((unsigned char*)d_ws + WS_MISC + MO_CTL, 0, 4096, stream);
    Params p{};
    for (int i = 0; i < 34; ++i) p.in[i] = (const float*)d_in[i];
    p.out = (float*)d_out; p.ws = (unsigned char*)d_ws;
    void* args[] = {&p};
    hipError_t e = hipLaunchCooperativeKernel((const void*)fwd_megakernel, dim3(grid_blocks), dim3(512), args, LDS_BYTES, stream);
    if (e != hipSuccess) fprintf(stderr, "cooperative launch failed: %s (grid %d)\n", hipGetErrorString(e), grid_blocks);
}
```

```cpp
#include <hip/hip_runtime.h>
#include <hip/hip_cooperative_groups.h>
#include <cstdio>
#include <cstdint>
namespace cg = cooperative_groups;

#define LAS __attribute__((address_space(3)))
#define GAS __attribute__((address_space(1)))
typedef unsigned short bf16_t;
typedef short bf16x8 __attribute__((ext_vector_type(8)));
typedef float f32x4 __attribute__((ext_vector_type(4)));
typedef float f32x2 __attribute__((ext_vector_type(2)));
typedef unsigned u32x4 __attribute__((ext_vector_type(4)));
typedef unsigned u32x2 __attribute__((ext_vector_type(2)));

constexpr int T_TOK = 65536, DM = 1024, SEQ = 2048, NBATCH = 32;
constexpr float RMS_EPS = 1e-6f;
constexpr size_t MiB = 1u << 20;
constexpr size_t SLOT = 128 * MiB;
constexpr size_t WS_MISC = 7 * SLOT;
constexpr size_t MO_WIN = 0, MO_WGATE = 4 * MiB, MO_WOUT = 5 * MiB, MO_WRKV = 7 * MiB, MO_WL2 = 20 * MiB, MO_WBO = 22 * MiB,
                 MO_WQ = 24 * MiB, MO_WKV = 28 * MiB, MO_WCO = 36 * MiB, MO_WUP = 40 * MiB, MO_WDN = 56 * MiB, MO_MEMN = 72 * MiB,
                 MO_KMEM = 88 * MiB, MO_VTMEM = 104 * MiB, MO_SP = 120 * MiB;
constexpr size_t WS_NEED = WS_MISC + 122 * MiB;
constexpr int LDS_BYTES = 147456, LDS_MISC_OFF = 131072;

struct Params { const float* in[34]; float* out; unsigned char* ws; };

__device__ __forceinline__ unsigned cvt_pk_bf16(float lo, float hi) { unsigned r; asm("v_cvt_pk_bf16_f32 %0, %1, %2" : "=v"(r) : "v"(lo), "v"(hi)); return r; }
__device__ __forceinline__ float bf_lo(unsigned w) { return __uint_as_float(w << 16); }
__device__ __forceinline__ float bf_hi(unsigned w) { return __uint_as_float(w & 0xffff0000u); }
__device__ __forceinline__ f32x4 unpack4(u32x2 w) { return (f32x4){bf_lo(w.x), bf_hi(w.x), bf_lo(w.y), bf_hi(w.y)}; }
__device__ __forceinline__ u32x2 pack4(f32x4 v) { u32x2 o; o.x = cvt_pk_bf16(v.x, v.y); o.y = cvt_pk_bf16(v.z, v.w); return o; }
__device__ __forceinline__ u32x4 pack8(f32x4 a, f32x4 b) { u32x4 o; o.x = cvt_pk_bf16(a.x, a.y); o.y = cvt_pk_bf16(a.z, a.w); o.z = cvt_pk_bf16(b.x, b.y); o.w = cvt_pk_bf16(b.z, b.w); return o; }
__device__ __forceinline__ float wave_sum(float v) {
#pragma unroll
    for (int o = 1; o < 64; o <<= 1) v += __shfl_xor(v, o);
    return v;
}
__device__ __forceinline__ float sum16(float v) {
    float a = v + __builtin_bit_cast(float, __builtin_amdgcn_mov_dpp(__builtin_bit_cast(int, v), 0xB1, 0xF, 0xF, true));
    a = a + __builtin_bit_cast(float, __builtin_amdgcn_mov_dpp(__builtin_bit_cast(int, a), 0x4E, 0xF, 0xF, true));
    a = a + __builtin_bit_cast(float, __builtin_amdgcn_mov_dpp(__builtin_bit_cast(int, a), 0x141, 0xF, 0xF, true));
    return a + __builtin_bit_cast(float, __builtin_amdgcn_mov_dpp(__builtin_bit_cast(int, a), 0x140, 0xF, 0xF, true));
}
__device__ __forceinline__ float quad_sum(float v) {
    float a = v + __builtin_bit_cast(float, __builtin_amdgcn_mov_dpp(__builtin_bit_cast(int, v), 0xB1, 0xF, 0xF, true));
    return a + __builtin_bit_cast(float, __builtin_amdgcn_mov_dpp(__builtin_bit_cast(int, a), 0x4E, 0xF, 0xF, true));
}
__device__ __forceinline__ int lane_opaque() { unsigned m = ~0u; asm volatile("" : "+s"(m)); int l = (int)__builtin_amdgcn_mbcnt_hi(m, __builtin_amdgcn_mbcnt_lo(m, 0u)); asm volatile("" : "+v"(l)); return l; }
__device__ __forceinline__ void grid_bar(unsigned* ctr, unsigned target, int wave) {
    asm volatile("s_waitcnt vmcnt(0) lgkmcnt(0)" ::: "memory");
    __builtin_amdgcn_s_barrier();
    if (wave == 0) {
        if (lane_opaque() == 0) {
            __builtin_amdgcn_fence(__ATOMIC_RELEASE, "agent");
            asm volatile("s_waitcnt vmcnt(0)" ::: "memory");
            __hip_atomic_fetch_add(ctr, 1u, __ATOMIC_RELAXED, __HIP_MEMORY_SCOPE_AGENT);
            unsigned spins = 0;
            while (__hip_atomic_load(ctr, __ATOMIC_RELAXED, __HIP_MEMORY_SCOPE_AGENT) < target) { __builtin_amdgcn_s_sleep(2); if (++spins > (1u << 23)) break; }
            __builtin_amdgcn_fence(__ATOMIC_ACQUIRE, "agent");
            asm volatile("s_waitcnt vmcnt(0)" ::: "memory");
        }
    }
    asm volatile("" ::: "memory");
    __builtin_amdgcn_s_barrier();
    asm volatile("" ::: "memory");
}
__device__ __forceinline__ float oct_sum(float v) {
    float a = quad_sum(v);
    return a + __builtin_bit_cast(float, __builtin_amdgcn_mov_dpp(__builtin_bit_cast(int, a), 0x141, 0xF, 0xF, true));
}
typedef _Float16 h16x2 __attribute__((ext_vector_type(2)));
__device__ __forceinline__ unsigned pk_h2(float lo, float hi) { f32x2 v = {lo, hi}; h16x2 h = __builtin_convertvector(v, h16x2); return __builtin_bit_cast(unsigned, h); }
__device__ __forceinline__ f32x4 unpack4h(u32x2 w) { const h16x2 a = __builtin_bit_cast(h16x2, w.x), b = __builtin_bit_cast(h16x2, w.y); return (f32x4){(float)a.x, (float)a.y, (float)b.x, (float)b.y}; }
__device__ __forceinline__ float row_scan16(float x) {
    x += __builtin_bit_cast(float, __builtin_amdgcn_update_dpp(0, __builtin_bit_cast(int, x), 0x111, 0xF, 0xF, false));
    x += __builtin_bit_cast(float, __builtin_amdgcn_update_dpp(0, __builtin_bit_cast(int, x), 0x112, 0xF, 0xF, false));
    x += __builtin_bit_cast(float, __builtin_amdgcn_update_dpp(0, __builtin_bit_cast(int, x), 0x114, 0xF, 0xF, false));
    x += __builtin_bit_cast(float, __builtin_amdgcn_update_dpp(0, __builtin_bit_cast(int, x), 0x118, 0xF, 0xF, false));
    return x;
}
__device__ __forceinline__ float sigm(float x) { return __builtin_amdgcn_rcpf(1.f + __expf(-x)); }
__device__ __forceinline__ float tanh_(float x) { return 1.f - 2.f * __builtin_amdgcn_rcpf(1.f + __expf(2.f * x)); }
__device__ __forceinline__ float gelu_tanh(float x) { return x * __builtin_amdgcn_rcpf(1.f + __expf(-1.5957691216f * (x + 0.044715f * x * x * x))); }
__device__ __forceinline__ float dot4(f32x4 a, f32x4 b) { return (a.x * b.x + a.y * b.y) + (a.z * b.z + a.w * b.w); }

namespace pg8 {
constexpr int BM = 256, BK = 64, HALF = 128, HTB = HALF * BK * 2, STAGE_BYTES = 8 * HTB, NXCD = 8, WGM = 8;
__device__ __forceinline__ int lds_byte(int r, int c) { const int st = (r >> 4) * 2 + (c >> 5), rr = r & 15, cc = c & 31, ob = rr * 64 + cc * 2; return st * 1024 + (ob ^ (((ob >> 9) & 1) << 5)); }
__device__ __forceinline__ void stage_rc(int b, int& R, int& C) { const int st = b / 1024, sb = b % 1024, swz = sb ^ (((sb >> 9) & 1) << 5); R = (st >> 1) * 16 + swz / 64; C = (st & 1) * 32 + (swz % 64) / 2; }
__device__ __forceinline__ int perm32(int rho) { const int n = rho >> 4, i = rho & 15; return 8 * (i >> 2) + 4 * n + (i & 3); }

struct Unit { int pm, pn; };
struct Gemm { const bf16_t* A; const bf16_t* B; int lda, ldb, K, acol_on, acol_shift, bbatch; };

struct Order {
    int nM, nN, nwg, G, c, panel;
    __device__ void init(int nM_, int nN_, int G_, int c_, int panel_ = 0) { nM = nM_; nN = nN_; nwg = nM * nN; G = G_; c = c_; panel = panel_; }
    __device__ bool next(int i, Unit& u) const {
        if (panel) { if (i >= nN || c >= nM) return false; u.pm = c; u.pn = i; return true; }
        const long L = (long)i * G + c; if (L >= nwg) return false;
        int wgid = (int)L; { const int q = nwg / NXCD, r = nwg % NXCD, xcd = wgid % NXCD, off = wgid / NXCD; wgid = (xcd < r ? xcd * (q + 1) : r * (q + 1) + (xcd - r) * q) + off; }
        const int nig = WGM * nN, gid = wgid / nig, fm = gid * WGM, gsz = (nM - fm) < WGM ? (nM - fm) : WGM;
        u.pm = fm + ((wgid % nig) % gsz); u.pn = (wgid % nig) / gsz; return true;
    }
};

template <class Epi, bool ALIGN_EPI>
__device__ __forceinline__ void gemm_phase(LAS unsigned char* lds, const Gemm g, const Order& S, const Epi& E, int wave) {
    const int lane = lane_opaque(), wid = wave, tid = wid * 64 + lane, wr = wid >> 2, wc = wid & 3, fr = lane & 15, fq = lane >> 4;
    const int nt = g.K / BK;
    unsigned voffA[2], voffB[2];
#pragma unroll
    for (int i = 0; i < 2; ++i) { int R, C; stage_rc(tid * 16 + i * 8192, R, C); const int Rb = (R & ~31) + perm32(R & 31);
        voffA[i] = (unsigned)(R * g.lda + C) * 2u; voffB[i] = (unsigned)(Rb * g.ldb + C) * 2u; }
    const size_t kstep = (size_t)(BK * 2);
    const size_t hstepA = (size_t)HALF * g.lda * 2, hstepB = (size_t)HALF * g.ldb * 2;
    const unsigned ldsw = (unsigned)wid * 1024u;
    const int aoff = lds_byte(wr * 64 + fr, fq * 8), boff = lds_byte(wc * 32 + fr, fq * 8);
#define PG8_APTR(u) ((const char*)g.A + ((size_t)(u).pm * 256 * g.lda + (g.acol_on ? (size_t)(((u).pn >> g.acol_shift) * 256) : (size_t)0)) * 2)
#define PG8_BPTR(u) ((const char*)g.B + (size_t)(((u).pm >> 3) * g.bbatch + (u).pn) * 256 * g.ldb * 2)
#define PG8_SA(b, h) (((b) * 2 + (h)) * HTB)
#define PG8_SB(b, h) ((4 + (b) * 2 + (h)) * HTB)
#define PG8_STAGE(bufoff, gbase, voff) do { _Pragma("unroll") for (int _i = 0; _i < 2; ++_i) \
        __builtin_amdgcn_global_load_lds((const unsigned*)((const char*)(gbase) + (voff)[_i]), (LAS unsigned*)(lds + (bufoff) + ldsw + _i * 8192), 16, 0, 0); } while (0)
#define PG8_LDA(dst, b, h) do { _Pragma("unroll") for (int m = 0; m < 4; ++m) _Pragma("unroll") for (int k = 0; k < 2; ++k) dst[m][k] = *(const LAS bf16x8*)(lds + PG8_SA(b, h) + aoff + m * 2048 + k * 1024); } while (0)
#define PG8_LDB(dst, b, h) do { _Pragma("unroll") for (int n = 0; n < 2; ++n) _Pragma("unroll") for (int k = 0; k < 2; ++k) dst[n][k] = *(const LAS bf16x8*)(lds + PG8_SB(b, h) + boff + n * 2048 + k * 1024); } while (0)
#define PG8_MMA(ai, bj, At, Bt) do { __builtin_amdgcn_s_setprio(1); _Pragma("unroll") for (int m = 0; m < 4; ++m) _Pragma("unroll") for (int n = 0; n < 2; ++n) _Pragma("unroll") for (int k = 0; k < 2; ++k) \
        acc[ai][bj][m][n] = __builtin_amdgcn_mfma_f32_16x16x32_bf16(Bt[n][k], At[m][k], acc[ai][bj][m][n], 0, 0, 0); __builtin_amdgcn_s_setprio(0); } while (0)
#define PG8_WAIT_V(n) asm volatile("s_waitcnt vmcnt(" #n ")" ::: "memory")
#define PG8_WAIT_L(n) asm volatile("s_waitcnt lgkmcnt(" #n ")" ::: "memory")
#define PG8_BAR __builtin_amdgcn_s_barrier()
#define PG8_SCHED __builtin_amdgcn_sched_barrier(0)
    Unit cur, nxt; int ui = 0;
    if (!S.next(0, cur)) return;
    f32x4 acc[2][2][4][2];
#pragma unroll
    for (int a = 0; a < 2; ++a)
#pragma unroll
        for (int b = 0; b < 2; ++b)
#pragma unroll
            for (int m = 0; m < 4; ++m)
#pragma unroll
                for (int n = 0; n < 2; ++n) acc[a][b][m][n] = (f32x4){0.f, 0.f, 0.f, 0.f};
    bf16x8 At[4][2], B0[2][2], B1[2][2];
    const char* cA = PG8_APTR(cur); const char* cB = PG8_BPTR(cur);
    PG8_STAGE(PG8_SB(0, 0), cB, voffB); PG8_STAGE(PG8_SB(0, 1), cB + hstepB, voffB); PG8_STAGE(PG8_SA(0, 0), cA, voffA); PG8_STAGE(PG8_SA(0, 1), cA + hstepA, voffA);
    if (wr == 1) PG8_BAR;
    PG8_WAIT_V(2); PG8_BAR;
    PG8_STAGE(PG8_SB(1, 0), cB + kstep, voffB); PG8_STAGE(PG8_SA(1, 0), cA + kstep, voffA); PG8_STAGE(PG8_SB(1, 1), cB + hstepB + kstep, voffB);
    PG8_WAIT_V(6); PG8_BAR;
    for (;;) {
        const bool has_next = S.next(ui + 1, nxt);
        const char* nA = has_next ? PG8_APTR(nxt) : cA; const char* nB = has_next ? PG8_BPTR(nxt) : cB;
#pragma unroll 1
        for (int t = 0; t < nt; t += 2) {
            const bool last = (t == nt - 2);
            const char* a1 = cA + (size_t)(t + 1) * kstep;
            const char* a2 = last ? nA : cA + (size_t)(t + 2) * kstep; const char* b2 = last ? nB : cB + (size_t)(t + 2) * kstep;
            const char* a3 = a2 + kstep; const char* b3 = b2 + kstep;
            PG8_LDB(B0, 0, 0); PG8_LDB(B1, 0, 1); PG8_SCHED; PG8_LDA(At, 0, 0); PG8_STAGE(PG8_SA(1, 1), a1 + hstepA, voffA);
            PG8_WAIT_V(8); PG8_WAIT_L(0); PG8_BAR; PG8_MMA(0, 0, At, B0); PG8_MMA(0, 1, At, B1); PG8_BAR; PG8_SCHED;
            PG8_LDA(At, 0, 1); PG8_STAGE(PG8_SB(0, 0), b2, voffB); PG8_STAGE(PG8_SB(0, 1), b2 + hstepB, voffB); PG8_STAGE(PG8_SA(0, 0), a2, voffA);
            PG8_WAIT_V(8); PG8_WAIT_L(0); PG8_BAR; PG8_MMA(1, 0, At, B0); PG8_MMA(1, 1, At, B1); PG8_BAR; PG8_SCHED;
            PG8_LDB(B0, 1, 0); PG8_LDB(B1, 1, 1); PG8_SCHED; PG8_LDA(At, 1, 0); PG8_STAGE(PG8_SA(0, 1), a2 + hstepA, voffA);
            PG8_WAIT_V(8); PG8_WAIT_L(0); PG8_BAR; PG8_MMA(0, 0, At, B0); PG8_MMA(0, 1, At, B1); PG8_BAR; PG8_SCHED;
            PG8_LDA(At, 1, 1); PG8_STAGE(PG8_SB(1, 0), b3, voffB); PG8_STAGE(PG8_SB(1, 1), b3 + hstepB, voffB); PG8_STAGE(PG8_SA(1, 0), a3, voffA);
            PG8_WAIT_V(8); PG8_WAIT_L(0); PG8_BAR; PG8_MMA(1, 0, At, B0); PG8_MMA(1, 1, At, B1); PG8_BAR; PG8_SCHED;
        }
        if constexpr (ALIGN_EPI) { if (wr == 0) PG8_BAR; }
        E(acc, cur, wr, wc, fr, fq, lds + LDS_MISC_OFF);
        if (!has_next) break;
#pragma unroll
        for (int a = 0; a < 2; ++a)
#pragma unroll
            for (int b = 0; b < 2; ++b)
#pragma unroll
                for (int m = 0; m < 4; ++m)
#pragma unroll
                    for (int n = 0; n < 2; ++n) acc[a][b][m][n] = (f32x4){0.f, 0.f, 0.f, 0.f};
        cur = nxt; cA = nA; cB = nB; ++ui;
        if constexpr (ALIGN_EPI) { if (wr == 1) PG8_BAR; }
    }
    PG8_WAIT_V(0);
    if constexpr (!ALIGN_EPI) { if (wr == 0) PG8_BAR; }
    PG8_BAR;
#undef PG8_APTR
#undef PG8_BPTR
#undef PG8_SA
#undef PG8_SB
#undef PG8_STAGE
#undef PG8_LDA
#undef PG8_LDB
#undef PG8_MMA
#undef PG8_WAIT_V
#undef PG8_WAIT_L
#undef PG8_BAR
#undef PG8_SCHED
}

template <class F> struct Epi {
    F f;
    __device__ __forceinline__ void operator()(f32x4 (&acc)[2][2][4][2], const Unit& u, int wr, int wc, int fr, int fq, LAS unsigned char*) const {
        asm volatile("" : "+v"(fr), "+v"(fq));
#pragma unroll
        for (int ai = 0; ai < 2; ++ai)
#pragma unroll
            for (int m = 0; m < 4; ++m) {
                const int r = ai * HALF + wr * 64 + m * 16 + fr;
#pragma unroll
                for (int bj = 0; bj < 2; ++bj) f.emit(u, r, bj * HALF + wc * 32 + 8 * fq, acc[ai][bj][m][0], acc[ai][bj][m][1]);
            }
    }
};
}
using pg8::Unit;

template <int ACT> struct FStd {
    bf16_t* dst; int ldc; const float* bias; float scale;
    __device__ __forceinline__ void emit(const Unit& u, int r, int c0, f32x4 v0, f32x4 v1) const {
        const int col = u.pn * 256 + c0; const size_t row = (size_t)u.pm * 256 + r;
        if (bias) { v0 += *(const GAS f32x4*)(bias + col); v1 += *(const GAS f32x4*)(bias + col + 4); }
        v0 *= scale; v1 *= scale;
        if (ACT == 1) {
#pragma unroll
            for (int e = 0; e < 4; ++e) { float a = fmaxf(v0[e], 0.f); v0[e] = a * a; float b = fmaxf(v1[e], 0.f); v1[e] = b * b; }
        }
        *(GAS u32x4*)(dst + row * ldc + col) = pack8(v0, v1);
    }
};
struct FTile {
    bf16_t* dst; int mulm, muln;
    __device__ __forceinline__ void emit(const Unit& u, int r, int c0, f32x4 v0, f32x4 v1) const {
        *(GAS u32x4*)(dst + (size_t)(u.pm * mulm + u.pn * muln) * 65536 + r * 256 + c0) = pack8(v0, v1);
    }
};
struct FWin {
    bf16_t* Y; bf16_t* U; const float* bias;
    __device__ __forceinline__ void emit(const Unit& u, int r, int c0, f32x4 v0, f32x4 v1) const {
        const int col = u.pn * 256 + c0; const size_t row = (size_t)u.pm * 256 + r;
        v0 += *(const GAS f32x4*)(bias + col); v1 += *(const GAS f32x4*)(bias + col + 4);
        if (u.pn < 4) {
#pragma unroll
            for (int e = 0; e < 4; ++e) { v0[e] = gelu_tanh(v0[e]); v1[e] = gelu_tanh(v1[e]); }
            *(GAS u32x4*)(Y + row * 1024 + col) = pack8(v0, v1);
        } else *(GAS u32x4*)(U + row * 1024 + (col - 1024)) = pack8(v0, v1);
    }
};
struct FLora {
    bf16_t* L;
    __device__ __forceinline__ void emit(const Unit& u, int r, int c0, f32x4 v0, f32x4 v1) const {
        const size_t row = (size_t)u.pm * 256 + r;
        if (c0 < 64) {
#pragma unroll
            for (int e = 0; e < 4; ++e) { v0[e] = tanh_(v0[e]); v1[e] = tanh_(v1[e]); }
        } else if (c0 >= 128) {
#pragma unroll
            for (int e = 0; e < 4; ++e) { v0[e] = sigm(v0[e]); v1[e] = sigm(v1[e]); }
        }
        *(GAS u32x4*)(L + row * 1024 + c0) = pack8(v0, v1);
    }
};
struct FL2 {
    unsigned char* ws; const float* w0; const float* a0;
    __device__ __forceinline__ void emit(const Unit& u, int r, int c0, f32x4 v0, f32x4 v1) const {
        const size_t row = (size_t)u.pm * 256 + r; const int ch = (u.pn & 3) * 256 + c0; const int w = u.pn >> 2;
        bf16_t* d = (bf16_t*)(ws + (size_t)(3 + w) * SLOT);
        if (w == 0) { v0 += *(const GAS f32x4*)(w0 + ch); v1 += *(const GAS f32x4*)(w0 + ch + 4);
#pragma unroll
            for (int e = 0; e < 4; ++e) { v0[e] = 0.60653066f * sigm(v0[e]); v1[e] = 0.60653066f * sigm(v1[e]); }
#pragma unroll
            for (int e = 0; e < 4; ++e) { v0[e] = row_scan16(v0[e]); v1[e] = row_scan16(v1[e]); }
            *(GAS u32x4*)(d + row * 1024 + ch) = pack8(v0, v1);
            return;
            }
        else if (w == 1) { v0 += *(const GAS f32x4*)(a0 + ch); v1 += *(const GAS f32x4*)(a0 + ch + 4);
#pragma unroll
            for (int e = 0; e < 4; ++e) { v0[e] = sigm(v0[e]); v1[e] = sigm(v1[e]); }
            }
        *(GAS u32x4*)(d + row * 1024 + ch) = pack8(v0, v1);
    }
};
struct EpiGate {
    const bf16_t* C; const float* gate_b; const float* sp; bf16_t* LA; bf16_t* BV;
    __device__ __forceinline__ void operator()(f32x4 (&acc)[2][2][4][2], const Unit& u, int wr, int wc, int fr, int fq, LAS unsigned char*) const {
        asm volatile("" : "+v"(fr), "+v"(fq));
        const int ch0 = (u.pn >> 1) * 256 + (u.pn & 1) * 128 + wc * 32 + 8 * fq;
        f32x4 br[2], bi[2], s[2];
#pragma unroll
        for (int n = 0; n < 2; ++n) { br[n] = *(const GAS f32x4*)(gate_b + ch0 + 4 * n); bi[n] = *(const GAS f32x4*)(gate_b + 1024 + ch0 + 4 * n); s[n] = *(const GAS f32x4*)(sp + ch0 + 4 * n); }
#pragma unroll
        for (int ai = 0; ai < 2; ++ai)
#pragma unroll
            for (int m = 0; m < 4; ++m) {
                const size_t row = (size_t)u.pm * 256 + ai * 128 + wr * 64 + m * 16 + fr;
                const u32x4 cw = *(const GAS u32x4*)(C + row * 1024 + ch0);
                f32x4 cv[2]; cv[0] = (f32x4){bf_lo(cw.x), bf_hi(cw.x), bf_lo(cw.y), bf_hi(cw.y)}; cv[1] = (f32x4){bf_lo(cw.z), bf_hi(cw.z), bf_lo(cw.w), bf_hi(cw.w)};
                f32x4 la[2], bb[2];
#pragma unroll
                for (int n = 0; n < 2; ++n)
#pragma unroll
                    for (int e = 0; e < 4; ++e) {
                        const float rg = sigm(acc[ai][0][m][n][e] + br[n][e]), ig = sigm(acc[ai][1][m][n][e] + bi[n][e]);
                        const float l = -8.0f * rg * s[n][e];
                        const float mult = sqrtf(fmaxf(1.f - __expf(2.f * l), 0.f));
                        la[n][e] = l; bb[n][e] = mult * ig * cv[n][e];
                    }
                *(GAS u32x4*)(LA + row * 1024 + ch0) = pack8(la[0], la[1]);
                *(GAS u32x4*)(BV + row * 1024 + ch0) = pack8(bb[0], bb[1]);
            }
    }
};
struct EpiSoftmax {
    bf16_t* P;
    __device__ __forceinline__ void operator()(f32x4 (&acc)[2][2][4][2], const Unit& u, int wr, int wc, int fr, int fq, LAS unsigned char* lm) const {
        asm volatile("" : "+v"(fr), "+v"(fq));
        LAS float* xmax = (LAS float*)lm; LAS float* xsum = (LAS float*)(lm + 4096);
#pragma unroll
        for (int ai = 0; ai < 2; ++ai)
#pragma unroll
            for (int m = 0; m < 4; ++m) {
                float mx = -3.0e38f;
#pragma unroll
                for (int bj = 0; bj < 2; ++bj)
#pragma unroll
                    for (int n = 0; n < 2; ++n)
#pragma unroll
                        for (int e = 0; e < 4; ++e) mx = fmaxf(mx, acc[ai][bj][m][n][e]);
                mx = fmaxf(mx, __shfl_xor(mx, 16)); mx = fmaxf(mx, __shfl_xor(mx, 32));
                if (fq == 0) xmax[(ai * 128 + wr * 64 + m * 16 + fr) * 4 + wc] = mx;
            }
        asm volatile("s_waitcnt lgkmcnt(0)" ::: "memory"); __builtin_amdgcn_s_barrier(); asm volatile("" ::: "memory");
#pragma unroll
        for (int ai = 0; ai < 2; ++ai)
#pragma unroll
            for (int m = 0; m < 4; ++m) {
                const int r = ai * 128 + wr * 64 + m * 16 + fr;
                const f32x4 mv = *(const LAS f32x4*)(xmax + r * 4);
                const float M = fmaxf(fmaxf(mv.x, mv.y), fmaxf(mv.z, mv.w));
                float sm = 0.f;
#pragma unroll
                for (int bj = 0; bj < 2; ++bj)
#pragma unroll
                    for (int n = 0; n < 2; ++n)
#pragma unroll
                        for (int e = 0; e < 4; ++e) { const float q = __expf(acc[ai][bj][m][n][e] - M); acc[ai][bj][m][n][e] = q; sm += q; }
                sm += __shfl_xor(sm, 16); sm += __shfl_xor(sm, 32);
                if (fq == 0) xsum[r * 4 + wc] = sm;
            }
        asm volatile("s_waitcnt lgkmcnt(0)" ::: "memory"); __builtin_amdgcn_s_barrier(); asm volatile("" ::: "memory");
#pragma unroll
        for (int ai = 0; ai < 2; ++ai)
#pragma unroll
            for (int m = 0; m < 4; ++m) {
                const int r = ai * 128 + wr * 64 + m * 16 + fr;
                const f32x4 sv = *(const LAS f32x4*)(xsum + r * 4);
                const float inv = 1.0f / ((sv.x + sv.y) + (sv.z + sv.w));
                bf16_t* rowp = P + ((size_t)u.pm * 256 + r) * 1024 + u.pn * 256 + wc * 32 + 8 * fq;
#pragma unroll
                for (int bj = 0; bj < 2; ++bj) {
                    *(GAS u32x4*)(rowp + bj * 128) = pack8(acc[ai][bj][m][0] * inv, acc[ai][bj][m][1] * inv);
                }
            }
    }
};

struct TJob { const float* W; int ldw, K, N; bf16_t* WT; int ldwt, row_off, col_off; const float* mu; float s0, s1; };

__device__ __forceinline__ void get_job(int j, const Params& p, TJob& J) {
    bf16_t* mb = (bf16_t*)(p.ws + WS_MISC);
    J.mu = nullptr; J.s0 = 1.f; J.s1 = 0.f; J.row_off = 0; J.col_off = 0;
    if (j == 0) { J.W = p.in[6]; J.ldw = 2048; J.K = 1024; J.N = 2048; J.WT = mb + MO_WIN / 2; J.ldwt = 1024; }
    else if (j < 17) { const int idx = j - 1, gg = idx >> 3, h = (idx >> 1) & 3, half = idx & 1;
        J.W = p.in[8] + (size_t)(gg * 4 + h) * 65536 + half * 128; J.ldw = 256; J.K = 256; J.N = 128; J.WT = mb + MO_WGATE / 2; J.ldwt = 256; J.row_off = (h * 2 + half) * 256 + gg * 128; }
    else if (j == 17) { J.W = p.in[11]; J.ldw = 1024; J.K = 1024; J.N = 1024; J.WT = mb + MO_WOUT / 2; J.ldwt = 1024; }
    else if (j < 24) { const int idx = j - 18, m = idx >> 1, part = idx & 1; const int mi = (m == 0) ? 0 : (m == 1 ? 2 : 3);
        J.W = p.in[14] + (size_t)m * 1048576; J.ldw = 1024; J.K = part ? 0 : 1024; J.N = 1024; J.WT = mb + MO_WRKV / 2; J.ldwt = 1024; J.row_off = m * 1024; (void)mi; }
    else if (j < 30) { const int idx = j - 24, w = idx >> 1, part = idx & 1;
        J.W = (w == 0) ? p.in[16] : (w == 1 ? p.in[19] : p.in[21]); J.N = (w == 2) ? 128 : 64; J.ldw = J.N; J.K = 1024; J.WT = mb + (MO_WRKV + 6 * MiB) / 2; J.ldwt = 2048;
        J.row_off = w * 64; J.col_off = part * 1024; J.mu = p.in[13] + ((w == 0) ? 1 : (w == 1 ? 4 : 5)) * 1024; J.s0 = part ? 0.f : 1.f; J.s1 = part ? 1.f : -1.f; }
    else if (j < 33) { const int w = j - 30;
        J.W = (w == 0) ? p.in[17] : (w == 1 ? p.in[20] : p.in[22]); J.ldw = 1024; J.K = (w == 2) ? 128 : 64; J.N = 1024; J.WT = mb + MO_WL2 / 2; J.ldwt = 256; J.row_off = w * 1024; J.col_off = w * 64; }
    else if (j == 33) { J.W = p.in[28]; J.ldw = 1024; J.K = 1024; J.N = 1024; J.WT = mb + MO_WBO / 2; J.ldwt = 1024; }
    else { const int idx = j - 34, l = idx / 5, kind = idx % 5;
        if (kind == 0)      { J.W = p.in[29] + (size_t)l * 1048576; J.ldw = 1024; J.K = 1024; J.N = 1024; J.WT = mb + MO_WQ / 2 + (size_t)l * 1048576; J.ldwt = 1024; }
        else if (kind == 1) { J.W = p.in[30] + (size_t)l * 2097152; J.ldw = 2048; J.K = 1024; J.N = 2048; J.WT = mb + MO_WKV / 2 + (size_t)l * 2097152; J.ldwt = 1024; }
        else if (kind == 2) { J.W = p.in[31] + (size_t)l * 1048576; J.ldw = 1024; J.K = 1024; J.N = 1024; J.WT = mb + MO_WCO / 2 + (size_t)l * 1048576; J.ldwt = 1024; }
        else if (kind == 3) { J.W = p.in[32] + (size_t)l * 4194304; J.ldw = 4096; J.K = 1024; J.N = 4096; J.WT = mb + MO_WUP / 2 + (size_t)l * 4194304; J.ldwt = 1024; }
        else                { J.W = p.in[33] + (size_t)l * 4194304; J.ldw = 1024; J.K = 4096; J.N = 1024; J.WT = mb + MO_WDN / 2 + (size_t)l * 4194304; J.ldwt = 4096; }
    }
}
constexpr int N_TJOBS = 44;

__device__ __forceinline__ void transpose_item(const TJob& J, LAS float* scr, int item, int lane) {
    const int nblk = J.N / 32, kb = item / nblk, nb = item % nblk, k0 = 64 * kb, n0 = 32 * nb;
#pragma unroll 8
    for (int i = 0; i < 32; ++i) { const int kk = 2 * i + (lane >> 5);
        const float sc = J.mu ? (J.s0 + J.s1 * J.mu[k0 + kk]) : 1.f;
        scr[kk * 33 + (lane & 31)] = J.W[(size_t)(k0 + kk) * J.ldw + n0 + (lane & 31)] * sc; }
    asm volatile("s_waitcnt lgkmcnt(0)" ::: "memory");
    const int c = lane & 7;
#pragma unroll
    for (int j = 0; j < 4; ++j) { const int n = (lane >> 3) + 8 * j; const LAS float* s = scr + (8 * c) * 33 + n;
        u32x4 o; o.x = cvt_pk_bf16(s[0 * 33], s[1 * 33]); o.y = cvt_pk_bf16(s[2 * 33], s[3 * 33]); o.z = cvt_pk_bf16(s[4 * 33], s[5 * 33]); o.w = cvt_pk_bf16(s[6 * 33], s[7 * 33]);
        *(GAS u32x4*)(J.WT + (size_t)(J.row_off + n0 + n) * J.ldwt + J.col_off + k0 + 8 * c) = o; }
    asm volatile("s_waitcnt lgkmcnt(0)" ::: "memory");
}

__device__ __forceinline__ void norm_rows(const float* src, const float* g, bf16_t* dst, int nrows, int gw, int ngw, int lane) {
    f32x4 gv[4];
#pragma unroll
    for (int j = 0; j < 4; ++j) gv[j] = *(const GAS f32x4*)(g + 4 * lane + 256 * j);
    f32x4 v[4], vn[4];
    if (gw < nrows) { const GAS f32x4* xp = (const GAS f32x4*)(src + (size_t)gw * 1024) + lane;
#pragma unroll
        for (int j = 0; j < 4; ++j) v[j] = xp[64 * j]; }
    for (int r = gw; r < nrows; r += ngw) {
        if (r + ngw < nrows) { const GAS f32x4* xp = (const GAS f32x4*)(src + (size_t)(r + ngw) * 1024) + lane;
#pragma unroll
            for (int j = 0; j < 4; ++j) vn[j] = xp[64 * j]; }
        float ss = 0.f;
#pragma unroll
        for (int j = 0; j < 4; ++j) ss += dot4(v[j], v[j]);
        const float rs = rsqrtf(wave_sum(ss) * (1.f / 1024.f) + RMS_EPS);
        GAS u32x2* op = (GAS u32x2*)(dst + (size_t)r * 1024) + lane;
#pragma unroll
        for (int j = 0; j < 4; ++j) { op[64 * j] = pack4(v[j] * rs * gv[j]); v[j] = vn[j]; }
    }
}

__device__ __forceinline__ void prologue_phase(const Params& p, LAS unsigned char* lds, int gw, int ngw, int wave, int lane) {
    LAS float* scr = (LAS float*)(lds + wave * 16384);
    int base = 0;
    for (int j = 0; j < N_TJOBS; ++j) {
        TJob J; get_job(j, p, J);
        const int n = (J.K / 64) * (J.N / 32);
        int first = (gw - (base % ngw) + ngw) % ngw;
        for (int it = first; it < n; it += ngw) transpose_item(J, scr, it, lane);
        base += n;
    }
    bf16_t* mb = (bf16_t*)(p.ws + WS_MISC);
    { bf16_t* wl2 = mb + MO_WL2 / 2; const int gt = gw * 64 + lane, ngt = ngw * 64;
      for (int i = gt; i < 3072 * 32; i += ngt) { const int row = i >> 5, c8 = (i & 31) * 8, w = row >> 10;
          const bool nz = (w == 0) ? (c8 < 64) : (w == 1 ? (c8 >= 64 && c8 < 128) : (c8 >= 128));
          if (!nz) *(GAS u32x4*)(wl2 + (size_t)row * 256 + c8) = (u32x4){0u, 0u, 0u, 0u}; }
      float* sp = (float*)(p.ws + WS_MISC + MO_SP);
      for (int i = gt; i < 1024; i += ngt) { const float y = -p.in[10][i]; sp[i] = fmaxf(y, 0.f) + __logf(1.f + __expf(-fabsf(y))); } }
    norm_rows(p.in[1], p.in[3], mb + MO_MEMN / 2, 8192, gw, ngw, lane);
    norm_rows(p.in[0], p.in[2], (bf16_t*)(p.ws + 0 * SLOT), T_TOK, gw, ngw, lane);
}

template <int MODE, int XS, int XD>
__device__ __forceinline__ void resnorm_phase(const bf16_t* tb, const void* xsrc, void* xdst, const float* gpost, const float* gpre, bf16_t* xn, int gw, int ngw, int lane, int rend = T_TOK) {
    f32x4 gp[4], gq[4];
#pragma unroll
    for (int j = 0; j < 4; ++j) { gp[j] = *(const GAS f32x4*)(gpost + 4 * lane + 256 * j); gq[j] = MODE ? *(const GAS f32x4*)(gpre + 4 * lane + 256 * j) : (f32x4){0.f, 0.f, 0.f, 0.f}; }
    u32x2 tw[4], twn[4], twm[4], xb[4], xbn[4], xbm[4]; f32x4 xf[4], xfn[4], xfm[4];
#define RN_LOAD(row, TW, XF, XB) do { const GAS u32x2* tp_ = (const GAS u32x2*)(tb + (size_t)(row) * 1024) + lane; \
        const GAS f32x4* xp_ = (const GAS f32x4*)((const float*)xsrc + (size_t)(row) * 1024) + lane; const GAS u32x2* xbp_ = (const GAS u32x2*)((const bf16_t*)xsrc + (size_t)(row) * 1024) + lane; \
        _Pragma("unroll") for (int j = 0; j < 4; ++j) { TW[j] = tp_[64 * j]; if (XS == 0) XF[j] = xp_[64 * j]; else XB[j] = xbp_[64 * j]; } } while (0)
    if (gw < rend) RN_LOAD(gw, tw, xf, xb);
    if (gw + ngw < rend) RN_LOAD(gw + ngw, twn, xfn, xbn);
    for (int r = gw; r < rend; r += ngw) {
        if (r + 2 * ngw < rend) RN_LOAD(r + 2 * ngw, twm, xfm, xbm);
        f32x4 xv[4], tv[4];
#pragma unroll
        for (int j = 0; j < 4; ++j) { if (XS == 0) xv[j] = xf[j]; else xv[j] = unpack4(xb[j]); }
        float ss = 0.f;
#pragma unroll
        for (int j = 0; j < 4; ++j) { tv[j] = unpack4(tw[j]); ss += dot4(tv[j], tv[j]); }
        const float rs = rsqrtf(wave_sum(ss) * (1.f / 1024.f) + RMS_EPS);
        float s2 = 0.f;
        GAS f32x4* op = (GAS f32x4*)((float*)xdst + (size_t)r * 1024) + lane;
        GAS u32x2* obp = (GAS u32x2*)((bf16_t*)xdst + (size_t)r * 1024) + lane;
#pragma unroll
        for (int j = 0; j < 4; ++j) { xv[j] = xv[j] + tv[j] * rs * gp[j]; s2 += dot4(xv[j], xv[j]); if (XD == 0) op[64 * j] = xv[j]; else obp[64 * j] = pack4(xv[j]); }
        if (MODE) {
            const float rs2 = rsqrtf(wave_sum(s2) * (1.f / 1024.f) + RMS_EPS);
            if (MODE == 1) {
                GAS u32x2* o = (GAS u32x2*)(xn + (size_t)r * 1024) + lane;
#pragma unroll
                for (int j = 0; j < 4; ++j) o[64 * j] = pack4(xv[j] * rs2 * gq[j]);
            } else {
                GAS u32x2* o = (GAS u32x2*)(xn + (size_t)r * 2048) + lane;
                const bool has_next = ((r + 1) & (SEQ - 1)) != 0, first = (r & (SEQ - 1)) == 0;
#pragma unroll
                for (int j = 0; j < 4; ++j) { const u32x2 w = pack4(xv[j] * rs2 * gq[j]); o[64 * j] = w;
                    if (has_next) o[512 + 256 + 64 * j] = w;
                    if (first) { u32x2 zz; asm volatile("v_mov_b32 %0, 0\n\tv_mov_b32 %1, 0" : "=v"(zz.x), "=v"(zz.y)); o[256 + 64 * j] = zz; } }
            }
        }
#pragma unroll
        for (int j = 0; j < 4; ++j) { tw[j] = twn[j]; xf[j] = xfn[j]; xb[j] = xbn[j]; twn[j] = twm[j]; xfn[j] = xfm[j]; xbn[j] = xbm[j]; }
    }
#undef RN_LOAD
}

__device__ __forceinline__ void resnorm_mix_phase(const bf16_t* tb, const bf16_t* xsrc, bf16_t* xdst, const float* gpost, const float* gpre, const float* mu,
                                                  bf16_t* XC, bf16_t* XR, bf16_t* XK, bf16_t* XV, int gw, int ngw, int lane, int base = 0, int count = T_TOK / 32) {
    f32x4 gp[4], gq[4], mr[4], mk[4], mv[4];
#pragma unroll
    for (int j = 0; j < 4; ++j) { const int c = 4 * lane + 256 * j; gp[j] = *(const GAS f32x4*)(gpost + c); gq[j] = *(const GAS f32x4*)(gpre + c);
        mr[j] = *(const GAS f32x4*)(mu + c); mk[j] = *(const GAS f32x4*)(mu + 2 * 1024 + c); mv[j] = *(const GAS f32x4*)(mu + 3 * 1024 + c); }
    for (int blk = base + gw; blk < base + count; blk += ngw) {
        const int r0 = blk * 32;
        f32x4 prev[4];
#pragma unroll
        for (int j = 0; j < 4; ++j) prev[j] = (f32x4){0.f, 0.f, 0.f, 0.f};
        const int rr0 = ((r0 & (SEQ - 1)) == 0 ? 0 : -1);
        u32x2 tw[4], xw[4], twn[4], xwn[4];
#define RM_LOAD(row, TW, XW) do { const GAS u32x2* tp_ = (const GAS u32x2*)(tb + (size_t)(row) * 1024) + lane; const GAS u32x2* xbp_ = (const GAS u32x2*)(xsrc + (size_t)(row) * 1024) + lane; \
            _Pragma("unroll") for (int j = 0; j < 4; ++j) { TW[j] = tp_[64 * j]; XW[j] = xbp_[64 * j]; } } while (0)
        RM_LOAD(r0 + rr0, tw, xw);
        for (int rr = rr0; rr < 32; ++rr) {
            const int r = r0 + rr;
            if (rr + 1 < 32) RM_LOAD(r + 1, twn, xwn);
            f32x4 xv[4], tv[4];
            float ss = 0.f;
#pragma unroll
            for (int j = 0; j < 4; ++j) { tv[j] = unpack4(tw[j]); xv[j] = unpack4(xw[j]); ss += dot4(tv[j], tv[j]); }
            const float rs = rsqrtf(wave_sum(ss) * (1.f / 1024.f) + RMS_EPS);
            float s2 = 0.f;
#pragma unroll
            for (int j = 0; j < 4; ++j) { xv[j] = xv[j] + tv[j] * rs * gp[j]; s2 += dot4(xv[j], xv[j]); }
            const float rs2 = rsqrtf(wave_sum(s2) * (1.f / 1024.f) + RMS_EPS);
            f32x4 xn[4];
#pragma unroll
            for (int j = 0; j < 4; ++j) xn[j] = xv[j] * rs2 * gq[j];
            if (rr >= 0) {
                GAS u32x2* ox = (GAS u32x2*)(xdst + (size_t)r * 1024) + lane;
                GAS u32x2* oc = (GAS u32x2*)(XC + (size_t)r * 2048) + lane;
                GAS u32x2* o1 = (GAS u32x2*)(XR + (size_t)r * 1024) + lane; GAS u32x2* o2 = (GAS u32x2*)(XK + (size_t)r * 1024) + lane; GAS u32x2* o3 = (GAS u32x2*)(XV + (size_t)r * 1024) + lane;
#pragma unroll
                for (int j = 0; j < 4; ++j) { const f32x4 xx = prev[j] - xn[j];
                    ox[64 * j] = pack4(xv[j]); oc[64 * j] = pack4(xn[j]); oc[256 + 64 * j] = pack4(prev[j]);
                    o1[64 * j] = pack4(xn[j] + xx * mr[j]); o2[64 * j] = pack4(xn[j] + xx * mk[j]); o3[64 * j] = pack4(xn[j] + xx * mv[j]); }
            }
#pragma unroll
            for (int j = 0; j < 4; ++j) { prev[j] = xn[j]; tw[j] = twn[j]; xw[j] = xwn[j]; }
        }
#undef RM_LOAD
    }
}

__device__ __forceinline__ void conv_phase(const bf16_t* U, const float* cw, const float* cb, bf16_t* C, int gw, int ngw, int lane, int base = 0, int count = NBATCH * 256) {
    const int half = gw & 1, ch0 = half * 512 + lane * 8;
    f32x4 w[4][2], bias[2];
#pragma unroll
    for (int tap = 0; tap < 4; ++tap) { w[tap][0] = *(const GAS f32x4*)(cw + tap * 1024 + ch0); w[tap][1] = *(const GAS f32x4*)(cw + tap * 1024 + ch0 + 4); }
    bias[0] = *(const GAS f32x4*)(cb + ch0); bias[1] = *(const GAS f32x4*)(cb + ch0 + 4);
    for (int k_ = gw >> 1; k_ < count; k_ += ngw >> 1) {
        const int it = base + k_; const int b = it >> 8, tb = it & 255, t0 = tb * 8; const size_t rowbase = (size_t)b * SEQ;
        f32x4 rows[11][2];
#pragma unroll
        for (int k = 0; k < 11; ++k) { const int t = t0 - 3 + k; u32x4 q = (u32x4){0u, 0u, 0u, 0u};
            if (t >= 0) q = *(const GAS u32x4*)(U + (rowbase + t) * 1024 + ch0);
            rows[k][0] = (f32x4){bf_lo(q.x), bf_hi(q.x), bf_lo(q.y), bf_hi(q.y)}; rows[k][1] = (f32x4){bf_lo(q.z), bf_hi(q.z), bf_lo(q.w), bf_hi(q.w)}; }
#pragma unroll
        for (int o = 0; o < 8; ++o) { f32x4 a0 = bias[0], a1 = bias[1];
#pragma unroll
            for (int tap = 0; tap < 4; ++tap) { a0 += rows[o + tap][0] * w[tap][0]; a1 += rows[o + tap][1] * w[tap][1]; }
            *(GAS u32x4*)(C + (rowbase + t0 + o) * 1024 + ch0) = pack8(a0, a1); }
    }
}

__device__ __forceinline__ void lru_scan_a(const bf16_t* LA, const bf16_t* BV, float* SUMP, float* SUMH, int gw, int ngw, int lane, int base = 0, int count = 2048) {
    for (int it = base + gw; it < base + count; it += ngw) {
        const int b = it >> 6, chunk = (it >> 1) & 31, half = it & 1, ch0 = half * 512 + lane * 8;
        const size_t row0 = (size_t)b * SEQ + chunk * 64;
        float h[8], sl[8];
#pragma unroll
        for (int e = 0; e < 8; ++e) { h[e] = 0.f; sl[e] = 0.f; }
        for (int s0 = 0; s0 < 64; s0 += 8) {
            u32x4 lq[8], bq[8];
#pragma unroll
            for (int s = 0; s < 8; ++s) { lq[s] = *(const GAS u32x4*)(LA + (row0 + s0 + s) * 1024 + ch0); bq[s] = *(const GAS u32x4*)(BV + (row0 + s0 + s) * 1024 + ch0); }
#pragma unroll
            for (int s = 0; s < 8; ++s) {
                const float l[8] = {bf_lo(lq[s].x), bf_hi(lq[s].x), bf_lo(lq[s].y), bf_hi(lq[s].y), bf_lo(lq[s].z), bf_hi(lq[s].z), bf_lo(lq[s].w), bf_hi(lq[s].w)};
                const float bb[8] = {bf_lo(bq[s].x), bf_hi(bq[s].x), bf_lo(bq[s].y), bf_hi(bq[s].y), bf_lo(bq[s].z), bf_hi(bq[s].z), bf_lo(bq[s].w), bf_hi(bq[s].w)};
#pragma unroll
                for (int e = 0; e < 8; ++e) { sl[e] += l[e]; h[e] = __expf(l[e]) * h[e] + bb[e]; }
            }
        }
        const size_t so = (size_t)(b * 32 + chunk) * 1024 + ch0;
        *(GAS f32x4*)(SUMP + so) = (f32x4){__expf(sl[0]), __expf(sl[1]), __expf(sl[2]), __expf(sl[3])}; *(GAS f32x4*)(SUMP + so + 4) = (f32x4){__expf(sl[4]), __expf(sl[5]), __expf(sl[6]), __expf(sl[7])};
        *(GAS f32x4*)(SUMH + so) = (f32x4){h[0], h[1], h[2], h[3]}; *(GAS f32x4*)(SUMH + so + 4) = (f32x4){h[4], h[5], h[6], h[7]};
    }
}
__device__ __forceinline__ void lru_scan_b(const bf16_t* LA, const bf16_t* BV, const bf16_t* Y, const float* SUMP, const float* SUMH, bf16_t* HY, int gw, int ngw, int lane, int base = 0, int count = 2048) {
    for (int it = base + gw; it < base + count; it += ngw) {
        const int b = it >> 6, chunk = (it >> 1) & 31, half = it & 1, ch0 = half * 512 + lane * 8;
        const size_t row0 = (size_t)b * SEQ + chunk * 64;
        float h[8];
#pragma unroll
        for (int e = 0; e < 8; ++e) h[e] = 0.f;
        for (int c = 0; c < chunk; ++c) {
            const size_t so = (size_t)(b * 32 + c) * 1024 + ch0;
            const f32x4 p0 = *(const GAS f32x4*)(SUMP + so), p1 = *(const GAS f32x4*)(SUMP + so + 4), h0 = *(const GAS f32x4*)(SUMH + so), h1 = *(const GAS f32x4*)(SUMH + so + 4);
#pragma unroll
            for (int e = 0; e < 4; ++e) { h[e] = p0[e] * h[e] + h0[e]; h[4 + e] = p1[e] * h[4 + e] + h1[e]; }
        }
        for (int s0 = 0; s0 < 64; s0 += 8) {
            u32x4 lq[8], bq[8], yq[8];
#pragma unroll
            for (int s = 0; s < 8; ++s) { lq[s] = *(const GAS u32x4*)(LA + (row0 + s0 + s) * 1024 + ch0); bq[s] = *(const GAS u32x4*)(BV + (row0 + s0 + s) * 1024 + ch0); yq[s] = *(const GAS u32x4*)(Y + (row0 + s0 + s) * 1024 + ch0); }
#pragma unroll
            for (int s = 0; s < 8; ++s) {
                const float l[8] = {bf_lo(lq[s].x), bf_hi(lq[s].x), bf_lo(lq[s].y), bf_hi(lq[s].y), bf_lo(lq[s].z), bf_hi(lq[s].z), bf_lo(lq[s].w), bf_hi(lq[s].w)};
                const float bb[8] = {bf_lo(bq[s].x), bf_hi(bq[s].x), bf_lo(bq[s].y), bf_hi(bq[s].y), bf_lo(bq[s].z), bf_hi(bq[s].z), bf_lo(bq[s].w), bf_hi(bq[s].w)};
                const float yy[8] = {bf_lo(yq[s].x), bf_hi(yq[s].x), bf_lo(yq[s].y), bf_hi(yq[s].y), bf_lo(yq[s].z), bf_hi(yq[s].z), bf_lo(yq[s].w), bf_hi(yq[s].w)};
                float o[8];
#pragma unroll
                for (int e = 0; e < 8; ++e) { h[e] = __expf(l[e]) * h[e] + bb[e]; o[e] = h[e] * yy[e]; }
                u32x4 w; w.x = cvt_pk_bf16(o[0], o[1]); w.y = cvt_pk_bf16(o[2], o[3]); w.z = cvt_pk_bf16(o[4], o[5]); w.w = cvt_pk_bf16(o[6], o[7]);
                *(GAS u32x4*)(HY + (row0 + s0 + s) * 1024 + ch0) = w;
            }
        }
    }
}

constexpr int RW_TC = 16;
#define RW_BAR() do { asm volatile("s_waitcnt lgkmcnt(0)" ::: "memory"); __builtin_amdgcn_s_barrier(); asm volatile("" ::: "memory"); } while (0)
typedef float f32x16 __attribute__((ext_vector_type(16)));
typedef __bf16 bf16x2_t __attribute__((ext_vector_type(2)));
__device__ __forceinline__ unsigned cvtpk_c(float lo, float hi) { f32x2 v = {lo, hi}; bf16x2_t b = __builtin_convertvector(v, bf16x2_t); return __builtin_bit_cast(unsigned, b); }
#define RW_MFMA(a, b, c) __builtin_amdgcn_mfma_f32_32x32x16_bf16((a), (b), (c), 0, 0, 0)
template <int SS> __device__ __forceinline__ bf16x8 rw_pack(const f32x16& x) {
    u32x4 p; p.x = cvtpk_c(x[8 * SS], x[8 * SS + 1]); p.y = cvtpk_c(x[8 * SS + 2], x[8 * SS + 3]); p.z = cvtpk_c(x[8 * SS + 4], x[8 * SS + 5]); p.w = cvtpk_c(x[8 * SS + 6], x[8 * SS + 7]);
    return __builtin_bit_cast(bf16x8, p);
}
constexpr int RW_IMG = 0, RW_BK = 4352, RW_VF = 8448, RW_CL = 12544, RW_BLK = 12800;
constexpr int RW_YB = 4 * RW_BLK, RW_FB = RW_YB + 16384, RW_TBL = RW_FB + 26112;
__device__ __forceinline__ f32x16 rw_round(const f32x16 (&XT)[2], const LAS unsigned char* img) {
    f32x16 Y;
#pragma unroll
    for (int q = 0; q < 16; ++q) Y[q] = 0.f;
    Y = RW_MFMA(*(const LAS bf16x8*)(img + 0),   rw_pack<0>(XT[0]), Y);
    Y = RW_MFMA(*(const LAS bf16x8*)(img + 64),  rw_pack<1>(XT[0]), Y);
    Y = RW_MFMA(*(const LAS bf16x8*)(img + 128), rw_pack<0>(XT[1]), Y);
    Y = RW_MFMA(*(const LAS bf16x8*)(img + 192), rw_pack<1>(XT[1]), Y);
    return Y;
}
struct RwOp { bf16x8 f0, f1, f2, f3; unsigned bk0, bk1; float vi; };
#define RW_DSR128(dst, addr, off) asm volatile("ds_read_b128 %0, %1 offset:%2" : "=v"(dst) : "v"(addr), "i"(off) : "memory")
#define RW_DSR32(dst, addr, off) asm volatile("ds_read_b32 %0, %1 offset:%2" : "=v"(dst) : "v"(addr), "i"(off) : "memory")
template <int T> __device__ __forceinline__ void rw_opissue(RwOp& o, unsigned img_a, unsigned bk_a, unsigned vf_a) {
    RW_DSR32(o.bk0, bk_a, T * 256); RW_DSR32(o.bk1, bk_a, T * 256 + 128); RW_DSR32(o.vi, vf_a, T * 256);
    RW_DSR128(o.f0, img_a, (T + 1) * 256); RW_DSR128(o.f1, img_a, (T + 1) * 256 + 64); RW_DSR128(o.f2, img_a, (T + 1) * 256 + 128); RW_DSR128(o.f3, img_a, (T + 1) * 256 + 192);
}
__device__ __forceinline__ void rw_opwait(RwOp& o) {
    asm volatile("s_waitcnt lgkmcnt(0)" : "+v"(o.f0), "+v"(o.f1), "+v"(o.f2), "+v"(o.f3), "+v"(o.bk0), "+v"(o.bk1), "+v"(o.vi) :: "memory");
}
template <int T> __device__ __forceinline__ void rw_step(f32x16 (&XT)[2], float& sa, RwOp& cur, unsigned img_a, unsigned bk_a, unsigned vf_a, int hl, LAS float* yrow) {
    rw_opwait(cur);
    RwOp nxt;
    if constexpr (T + 1 < RW_TC) rw_opissue<T + 1>(nxt, img_a, bk_a, vf_a);
    const u32x4 b3 = (u32x4){cvtpk_c(sa, cur.vi), 0u, 0u, 0u};
    const u32x4 a30 = (u32x4){hl ? 0u : cur.bk0, 0u, 0u, 0u}, a31 = (u32x4){hl ? 0u : cur.bk1, 0u, 0u, 0u};
    XT[0] = RW_MFMA(__builtin_bit_cast(bf16x8, a30), __builtin_bit_cast(bf16x8, b3), XT[0]);
    XT[1] = RW_MFMA(__builtin_bit_cast(bf16x8, a31), __builtin_bit_cast(bf16x8, b3), XT[1]);
    f32x16 Y;
#pragma unroll
    for (int q = 0; q < 16; ++q) Y[q] = 0.f;
    Y = RW_MFMA(cur.f0, rw_pack<0>(XT[0]), Y);
    Y = RW_MFMA(cur.f1, rw_pack<1>(XT[0]), Y);
    Y = RW_MFMA(cur.f2, rw_pack<0>(XT[1]), Y);
    Y = RW_MFMA(cur.f3, rw_pack<1>(XT[1]), Y);
    sa = Y[1];
    if (hl == 0) yrow[T * 64] = Y[0];
    if constexpr (T + 1 < RW_TC) rw_step<T + 1>(XT, sa, nxt, img_a, bk_a, vf_a, hl, yrow);
}
__device__ __forceinline__ void rwkv_stage(LAS unsigned char* blk, LAS float* fb, int st, int cq, u32x2 rr, u32x2 kr, u32x2 vr, u32x2 ar, u32x2 wcur, u32x2 wprv, const LAS float* cst) {
    asm volatile("" : "+v"(st), "+v"(cq));
    const f32x4 kk4 = *(const LAS f32x4*)(cst + cq * 4), ka4 = *(const LAS f32x4*)(cst + 64 + cq * 4), rk4 = *(const LAS f32x4*)(cst + 128 + cq * 4);
    const f32x4 r = unpack4(rr), k = unpack4(kr), v = unpack4(vr), a = unpack4(ar);
    const f32x4 incl = unpack4(wcur);
    f32x4 before = unpack4(wprv);
    if (st == 0) before = (f32x4){0.f, 0.f, 0.f, 0.f};
    f32x4 cprev, ct, ict;
#pragma unroll
    for (int e = 0; e < 4; ++e) { cprev[e] = __expf(-before[e]); ct[e] = __expf(-incl[e]); ict[e] = __expf(incl[e]); }
    const f32x4 kkr = k * kk4;
    const float ss = sum16(dot4(kkr, kkr));
    const float inv = 1.0f / fmaxf(sqrtf(ss), 1e-12f);
    const f32x4 kkn = kkr * inv;
    const f32x4 kp = k * (1.0f + (a - 1.0f) * ka4);
    const float bonus = sum16(dot4(r * kp, rk4));
    const f32x4 at = -kkn * cprev, rt = r * ct, bt = kkn * a * ict, kt = kp * ict;
    const int jb = cq >> 3, cl3 = cq & 7, s_ = cl3 >> 2, g_ = (cl3 >> 1) & 1, h_ = cl3 & 1;
    const int ioff = (jb * 2 + s_) * 64 + h_ * 32 + g_ * 8;
    *(LAS u32x2*)(blk + RW_IMG + (st + 1) * 256 + ioff) = pack4(rt);
    *(LAS u32x2*)(blk + RW_IMG + st * 256 + ioff + 16) = pack4(at);
    if (st == 15) *(LAS u32x2*)(blk + RW_IMG + 16 * 256 + ioff + 16) = (u32x2){0u, 0u};
    if (st == 0) *(LAS u32x2*)(blk + RW_IMG + ioff) = (u32x2){0u, 0u};
    u32x4 bkw; bkw.x = cvt_pk_bf16(bt.x, kt.x); bkw.y = cvt_pk_bf16(bt.y, kt.y); bkw.z = cvt_pk_bf16(bt.z, kt.z); bkw.w = cvt_pk_bf16(bt.w, kt.w);
    *(LAS u32x4*)(blk + RW_BK + st * 256 + cq * 16) = bkw;
    *(LAS f32x4*)(blk + RW_VF + st * 256 + cq * 16) = v;
    if (st == 15) *(LAS f32x4*)(blk + RW_CL + cq * 16) = ct;
    *(LAS f32x4*)(fb + st * 68 + cq * 4) = v;
    if (cq == 0) fb[st * 68 + 64] = bonus;
}
__device__ __forceinline__ void rwkv_scan_phase(LAS unsigned char* lds, const bf16_t* R, const bf16_t* Kb, const bf16_t* V, const bf16_t* W, const bf16_t* A, const bf16_t* G, bf16_t* Z,
                                                const float* k_k, const float* k_a, const float* r_k, const float* gn_g, const float* gn_b, int wave) {
    constexpr int TC = RW_TC, NCH = SEQ / TC;
    LAS float* ybuf = (LAS float*)(lds + RW_YB);
    LAS float* fbuf = (LAS float*)(lds + RW_FB);
    LAS int* tbl = (LAS int*)(lds + RW_TBL);
    const int lane = lane_opaque();
    int role = (wave < 4) ? wave : -1, hidx = (wave < 4) ? 0 : wave - 4;
    {
        const int simd = (int)(__builtin_amdgcn_s_getreg(4 | (4 << 6) | (1 << 11)) & 3u);
        if (lane == 0) tbl[wave] = simd;
        __syncthreads();
        int first[4] = {-1, -1, -1, -1};
#pragma unroll
        for (int w = 7; w >= 0; --w) { const int sd = tbl[w];
#pragma unroll
            for (int q = 0; q < 4; ++q) if (sd == q) first[q] = w; }
        if (first[0] >= 0 && first[1] >= 0 && first[2] >= 0 && first[3] >= 0) {
            role = -1; hidx = 0;
#pragma unroll
            for (int q = 0; q < 4; ++q) if (first[q] == wave) role = q;
#pragma unroll
            for (int w = 0; w < 8; ++w) { const bool isc = (first[0] == w) || (first[1] == w) || (first[2] == w) || (first[3] == w); if (w < wave && !isc) ++hidx; }
        }
        role = __builtin_amdgcn_readfirstlane(role); hidx = __builtin_amdgcn_readfirstlane(hidx) & 3;
        __syncthreads();
    }
    const bool comp = role >= 0; const int hc = (role >> 1) & 1, ib = role & 1, r32 = lane & 31, hl = lane >> 5;
    const int ht = hidx * 64 + lane, st = ht >> 4, cq = ht & 15;
    for (int pp = blockIdx.x; pp < 256; pp += gridDim.x) {
        const int pair = (4 * (pp & 7) + (pp >> 6)) * 8 + ((pp >> 3) & 7);
        if (comp) {
            f32x16 XT[2];
#pragma unroll
            for (int q = 0; q < 16; ++q) { XT[0][q] = 0.f; XT[1][q] = 0.f; }
            RW_BAR();
            for (int c = 0; c < NCH; ++c) {
                const LAS unsigned char* blk = lds + (hc * 2 + (c & 1)) * RW_BLK;
                const unsigned img_a = (unsigned)(size_t)(blk + RW_IMG + hl * 32 + (r32 & 1) * 16), bk_a = (unsigned)(size_t)(blk + RW_BK + r32 * 4), vf_a = (unsigned)(size_t)(blk + RW_VF + (ib * 32 + r32) * 4);
                LAS float* yrow = ybuf + (((c & 1) * 2 + hc) * TC) * 64 + ib * 32 + r32;
                RwOp op0; rw_opissue<0>(op0, img_a, bk_a, vf_a);
                float sa;
                { const f32x16 Y = rw_round(XT, blk + RW_IMG + hl * 32 + (r32 & 1) * 16); sa = Y[1]; }
                rw_step<0>(XT, sa, op0, img_a, bk_a, vf_a, hl, yrow);
#pragma unroll
                for (int q = 0; q < 16; ++q) { const int jr = (q & 3) + 8 * (q >> 2) + 4 * hl;
                    XT[0][q] *= *(const LAS float*)(blk + RW_CL + jr * 4); XT[1][q] *= *(const LAS float*)(blk + RW_CL + (32 + jr) * 4); }
                RW_BAR();
            }
            RW_BAR();
        } else {
            int col[2]; size_t rowbase[2];
            LAS float* cst = (LAS float*)(lds + RW_TBL + 64);
#pragma unroll
            for (int hh = 0; hh < 2; ++hh) { const int chain = pair * 2 + hh; col[hh] = (chain & 15) * 64 + cq * 4; rowbase[hh] = (size_t)(chain >> 4) * SEQ;
                if ((lane >> 4) == 0) { LAS float* c5 = cst + hh * 320 + cq * 4;
                    *(LAS f32x4*)(c5) = *(const GAS f32x4*)(k_k + col[hh]); *(LAS f32x4*)(c5 + 64) = *(const GAS f32x4*)(k_a + col[hh]); *(LAS f32x4*)(c5 + 128) = *(const GAS f32x4*)(r_k + col[hh]);
                    *(LAS f32x4*)(c5 + 192) = *(const GAS f32x4*)(gn_g + col[hh]); *(LAS f32x4*)(c5 + 256) = *(const GAS f32x4*)(gn_b + col[hh]); } }
            asm volatile("s_waitcnt lgkmcnt(0)" ::: "memory");
            u32x2 rr[2], kr[2], vr[2], ar[2], gr[2], wown[2], wprv[2];
#define RW_EOFF(hh, row) ({ int st_ = st, cq_ = cq; asm volatile("" : "+v"(st_), "+v"(cq_)); (size_t)(((pair * 2 + (hh)) >> 4) * SEQ + (row) + st_) * 1024 + (size_t)((((pair * 2 + (hh)) & 15) * 64) + cq_ * 4); })
#define RW_LOADS(chunk) do { _Pragma("unroll") for (int hh = 0; hh < 2; ++hh) { size_t o = RW_EOFF(hh, (chunk) * TC); asm volatile("" : "+v"(o));   \
                rr[hh] = *(const GAS u32x2*)(R + o); kr[hh] = *(const GAS u32x2*)(Kb + o); vr[hh] = *(const GAS u32x2*)(V + o); ar[hh] = *(const GAS u32x2*)(A + o); \
                wown[hh] = *(const GAS u32x2*)(W + o); wprv[hh] = *(const GAS u32x2*)(W + (st > 0 ? o - 1024 : o)); } } while (0)
#define RW_STAGE(chunk, f3) do { _Pragma("unroll") for (int hh = 0; hh < 2; ++hh) \
                rwkv_stage(lds + (hh * 2 + ((chunk) & 1)) * RW_BLK, fbuf + ((f3) * 2 + hh) * TC * 68, st, cq, rr[hh], kr[hh], vr[hh], ar[hh], wown[hh], wprv[hh], cst + hh * 320); } while (0)
            RW_LOADS(0);
            RW_STAGE(0, 0);
            RW_LOADS(1);
#pragma unroll
            for (int hh = 0; hh < 2; ++hh) gr[hh] = *(const GAS u32x2*)(G + RW_EOFF(hh, 0));
            RW_BAR();
            int c3 = 0;
            for (int c = 0; c <= NCH; ++c) {
                const int p3 = (c3 == 0) ? 2 : c3 - 1, n3 = (c3 == 2) ? 0 : c3 + 1;
                if (c >= 1) {
#pragma unroll
                    for (int hh = 0; hh < 2; ++hh) {
                        const f32x4 y4 = *(const LAS f32x4*)(ybuf + ((((c - 1) & 1) * 2 + hh) * TC + st) * 64 + cq * 4);
                        const LAS float* fb = fbuf + ((p3 * 2 + hh) * TC + st) * 68;
                        const f32x4 v4 = *(const LAS f32x4*)(fb + cq * 4); const float bonus = fb[64];
                        const float mean = sum16((y4.x + y4.y) + (y4.z + y4.w)) * (1.f / 64.f);
                        const f32x4 d = y4 - mean;
                        const float var = sum16(dot4(d, d)) * (1.f / 64.f);
                        const f32x4 yn = d * rsqrtf(var + 64e-5f) * *(const LAS f32x4*)(cst + hh * 320 + 192 + cq * 4) + *(const LAS f32x4*)(cst + hh * 320 + 256 + cq * 4);
                        const f32x4 o = (yn + v4 * bonus) * unpack4(gr[hh]);
                        *(GAS u32x2*)(Z + RW_EOFF(hh, (c - 1) * TC)) = pack4(o);
                    }
                }
                if (c < NCH) {
#pragma unroll
                    for (int hh = 0; hh < 2; ++hh) gr[hh] = *(const GAS u32x2*)(G + RW_EOFF(hh, c * TC));
                }
                if (c + 1 < NCH) RW_STAGE(c + 1, n3);
                if (c + 2 < NCH) RW_LOADS(c + 2);
                RW_BAR();
                c3 = n3;
            }
#undef RW_LOADS
#undef RW_EOFF
#undef RW_STAGE
        }
    }
}

constexpr size_t MO_CTL = 121 * MiB;
#define GSYNC() do { ++nbar; grid_bar(ctr, nbar * gridDim.x, wave); } while (0)
#define XSYNC() do { if (gridDim.x == 256) { ++nxbar; grid_bar(ctr + 64 * (1 + (blockIdx.x & 7)), nxbar * 32u, wave); } else GSYNC(); } while (0)
#define XPAN ((int)(32 * (blockIdx.x & 7) + (blockIdx.x >> 3)))
#define XGW ((int)((32 * (blockIdx.x & 7) + (blockIdx.x >> 3)) * 256 + wave))
#define XEND ((int)((32 * (blockIdx.x & 7) + (blockIdx.x >> 3)) * 256 + 256))
#define LSYNC() do { asm volatile("s_waitcnt vmcnt(0) lgkmcnt(0)" ::: "memory"); __builtin_amdgcn_s_barrier(); __builtin_amdgcn_fence(__ATOMIC_ACQUIRE, "agent"); \
        asm volatile("s_waitcnt vmcnt(0)" ::: "memory"); __builtin_amdgcn_s_barrier(); asm volatile("" ::: "memory"); } while (0)
#define PGW ((int)(blockIdx.x * 256 + wave))
#define PEND ((int)(blockIdx.x * 256 + 256))
#ifndef DUPMASK
#define DUPMASK 0
#endif
#define NREP(g) (1 + ((DUPMASK >> (g)) & 1))
#define RLAST(g) (rep_ == NREP(g) - 1)
#define PH(g, ...) _Pragma("unroll 1") for (int rep_ = 0; rep_ < NREP(g); ++rep_) { __VA_ARGS__; GSYNC(); }
template <class E>
__device__ __forceinline__ void run_gemm(LAS unsigned char* lds, const bf16_t* A, const bf16_t* B, int lda, int ldb, int K, int nM, int nN, int acol_on, int acol_shift, int bbatch, int cshift, const E& e, int wave) {
    pg8::Gemm g{A, B, lda, ldb, K, acol_on, acol_shift, bbatch};
    int G_ = (int)gridDim.x; asm volatile("" : "+s"(G_));
    pg8::Order S; if (cshift < 0) S.init(nM, nN, G_, (int)blockIdx.x, (nM == G_) ? 1 : 0); else S.init(nM, nN, G_, (int)((blockIdx.x + cshift) % G_));
    pg8::gemm_phase<E, true>(lds, g, S, e, wave);
}
__device__ __forceinline__ unsigned char* opqp(unsigned char* q) { asm volatile("" : "+s"(q)); return q; }
__device__ __forceinline__ int opqi(int i) { asm volatile("" : "+s"(i)); return i; }
#define SLOTP(i) ((bf16_t*)(opqp(p.ws) + (size_t)(i) * SLOT))
#define MBP(off) ((bf16_t*)(opqp(p.ws) + WS_MISC + (off)))
#define PIN(i) (p.in[opqi(i)])
#define XRES ((float*)opqp((unsigned char*)p.out))
#define GAINS PIN(2)
#define XRES2 ((void*)(opqp((unsigned char*)p.out) + SLOT))
#define GW opqi((int)(blockIdx.x * 8 + wave))
#define NGW opqi((int)(gridDim.x * 8))

__global__ void __launch_bounds__(512, 2) fwd_megakernel(Params p) {
    extern __shared__ __attribute__((aligned(16))) unsigned char lds_raw[];
    LAS unsigned char* lds = (LAS unsigned char*)lds_raw;
    const int wave = __builtin_amdgcn_readfirstlane(threadIdx.x >> 6);
    unsigned* ctr = (unsigned*)(p.ws + WS_MISC + MO_CTL);
    unsigned nbar = 0, nxbar = 0;

    prologue_phase(p, lds, GW, NGW, wave, lane_opaque()); cg::this_grid().sync();

    { pg8::Epi<FWin> e{{SLOTP(1), SLOTP(2), PIN(7)}}; run_gemm(lds, SLOTP(0), MBP(MO_WIN), 1024, 1024, 1024, 256, 8, 0, 0, 0, 0, e, wave); }
    { pg8::Epi<FTile> e{{MBP(MO_KMEM), 4, 1}}; run_gemm(lds, MBP(MO_MEMN), MBP(MO_WKV), 1024, 1024, 1024, 32, 4, 0, 0, 0, 0, e, wave); }
    { pg8::Epi<FTile> e{{MBP(MO_VTMEM), 1, 4}}; run_gemm(lds, MBP(MO_WKV) + 1048576, MBP(MO_MEMN), 1024, 1024, 1024, 4, 32, 0, 0, 0, 128, e, wave); }
    XSYNC();
    conv_phase(SLOTP(2), PIN(4), PIN(5), SLOTP(3), wave, 8, lane_opaque(), XPAN * 32, 32);
    XSYNC();
    { EpiGate e{SLOTP(3), PIN(9), (const float*)MBP(MO_SP), SLOTP(4), SLOTP(5)}; run_gemm(lds, SLOTP(3), MBP(MO_WGATE), 1024, 256, 256, 256, 8, 1, 1, 0, 0, e, wave); }
    XSYNC();
    lru_scan_a(SLOTP(4), SLOTP(5), (float*)SLOTP(6), (float*)SLOTP(6) + 1048576, wave, 8, lane_opaque(), XPAN * 8, 8);
    XSYNC();
    lru_scan_b(SLOTP(4), SLOTP(5), SLOTP(1), (const float*)SLOTP(6), (const float*)SLOTP(6) + 1048576, SLOTP(0), wave, 8, lane_opaque(), XPAN * 8, 8);
    XSYNC();
    { pg8::Epi<FStd<0>> e{{SLOTP(1), 1024, PIN(12), 1.f}}; run_gemm(lds, SLOTP(0), MBP(MO_WOUT), 1024, 1024, 1024, 256, 4, 0, 0, 0, 0, e, wave); }
    XSYNC();
    resnorm_phase<1, 0, 1>(SLOTP(1), PIN(0), XRES, GAINS + 1 * 1024, GAINS + 2 * 1024, SLOTP(0), XGW, 8, lane_opaque(), XEND); GSYNC();

#pragma unroll 1
    for (int l = 0; l < 2; ++l) {
        if (l == 1) {
            { pg8::Epi<FStd<0>> e{{SLOTP(1), 1024, nullptr, 1.f}}; run_gemm(lds, SLOTP(0), MBP(MO_WRKV), 1024, 1024, 1024, 256, 4, 0, 0, 0, 0, e, wave); }
            { pg8::Epi<FStd<0>> e{{SLOTP(6), 1024, nullptr, 1.f}}; run_gemm(lds, SLOTP(2), MBP(MO_WRKV) + 1048576, 1024, 1024, 1024, 256, 4, 0, 0, 0, 0, e, wave); }
            XSYNC();
            { pg8::Epi<FStd<0>> e{{SLOTP(0), 1024, nullptr, 1.f}}; run_gemm(lds, SLOTP(3), MBP(MO_WRKV) + 2097152, 1024, 1024, 1024, 256, 4, 0, 0, 0, 0, e, wave); }
            { pg8::Epi<FLora> e{{SLOTP(2)}}; run_gemm(lds, SLOTP(4), MBP(MO_WRKV + 6 * MiB), 2048, 2048, 2048, 256, 1, 0, 0, 0, 0, e, wave); }
            GSYNC();
            { pg8::Epi<FL2> e{{opqp(p.ws), PIN(15), PIN(18)}}; run_gemm(lds, SLOTP(2), MBP(MO_WL2), 1024, 256, 256, 256, 12, 0, 0, 0, 0, e, wave); }
            XSYNC();
            rwkv_scan_phase(lds, SLOTP(1), SLOTP(6), SLOTP(0), SLOTP(3), SLOTP(4), SLOTP(5), SLOTP(1), PIN(23), PIN(24), PIN(25), PIN(26), PIN(27), wave);
            XSYNC();
            { pg8::Epi<FStd<0>> e{{SLOTP(2), 1024, nullptr, 1.f}}; run_gemm(lds, SLOTP(1), MBP(MO_WBO), 1024, 1024, 1024, 256, 4, 0, 0, 0, 0, e, wave); }
            { pg8::Epi<FTile> e{{MBP(MO_KMEM), 4, 1}}; run_gemm(lds, MBP(MO_MEMN), MBP(MO_WKV) + (size_t)1 * 2097152, 1024, 1024, 1024, 32, 4, 0, 0, 0, 0, e, wave); }
            { pg8::Epi<FTile> e{{MBP(MO_VTMEM), 1, 4}}; run_gemm(lds, MBP(MO_WKV) + (size_t)1 * 2097152 + 1048576, MBP(MO_MEMN), 1024, 1024, 1024, 4, 32, 0, 0, 0, 128, e, wave); }
            XSYNC();
            resnorm_phase<1, 1, 1>(SLOTP(2), XRES2, XRES2, GAINS + (6 + 1) * 1024, GAINS + (6 + 2) * 1024, SLOTP(0), XGW, 8, lane_opaque(), XEND); GSYNC();
        }
        const float* gl = GAINS + l * 6 * 1024;
        { pg8::Epi<FStd<0>> e{{SLOTP(1), 1024, nullptr, 0.0625f}}; run_gemm(lds, SLOTP(0), MBP(MO_WQ) + (size_t)l * 1048576, 1024, 1024, 1024, 256, 4, 0, 0, 0, 0, e, wave); }
        { EpiSoftmax e{(bf16_t*)(l == 0 ? XRES2 : (void*)XRES)}; run_gemm(lds, SLOTP(1), MBP(MO_KMEM), 1024, 256, 256, 256, 4, 1, 0, 4, 0, e, wave); }
        { pg8::Epi<FStd<0>> e{{SLOTP(1), 1024, nullptr, 1.f}}; run_gemm(lds, (const bf16_t*)(l == 0 ? XRES2 : (void*)XRES), MBP(MO_VTMEM), 1024, 256, 256, 256, 4, 1, 0, 4, 0, e, wave); }
        XSYNC();
        { pg8::Epi<FStd<0>> e{{SLOTP(0), 1024, nullptr, 1.f}}; run_gemm(lds, SLOTP(1), MBP(MO_WCO) + (size_t)l * 1048576, 1024, 1024, 1024, 256, 4, 0, 0, 0, 0, e, wave); }
        XSYNC();
        resnorm_phase<1, 1, 1>(SLOTP(0), l == 0 ? (void*)XRES : (void*)XRES2, l == 0 ? (void*)XRES : (void*)SLOTP(6), gl + 3 * 1024, gl + 4 * 1024, SLOTP(1), XGW, 8, lane_opaque(), XEND);
        XSYNC();
        { pg8::Epi<FStd<1>> e{{SLOTP(2), 4096, nullptr, 1.f}}; run_gemm(lds, SLOTP(1), MBP(MO_WUP) + (size_t)l * 4194304, 1024, 1024, 1024, 256, 16, 0, 0, 0, 0, e, wave); }
        XSYNC();
        { pg8::Epi<FStd<0>> e{{SLOTP(1), 1024, nullptr, 1.f}}; run_gemm(lds, SLOTP(2), MBP(MO_WDN) + (size_t)l * 4194304, 4096, 4096, 4096, 256, 4, 0, 0, 0, 0, e, wave); }
        if (l == 0) { GSYNC();     resnorm_mix_phase(SLOTP(1), (const bf16_t*)XRES, (bf16_t*)XRES2, gl + 5 * 1024, GAINS + 6 * 1024, PIN(13), SLOTP(4), SLOTP(0), SLOTP(2), SLOTP(3), wave, 8, lane_opaque(), XPAN * 8, 8); XSYNC(); }
        else        { GSYNC();     resnorm_phase<0, 1, 0>(SLOTP(1), SLOTP(6), XRES, gl + 5 * 1024, nullptr, nullptr, XGW, 8, lane_opaque(), XEND); }
    }
}

extern "C" void kernel_launch(void* const* d_in, const int* in_sizes, int n_in, void* d_out, int out_size, void* d_ws, size_t ws_size, hipStream_t stream) {
    static int grid_blocks = 0;
    if (grid_blocks == 0) {
        if (n_in != 34 || out_size != T_TOK * DM || ws_size < WS_NEED) { fprintf(stderr, "kernel_launch: unexpected problem (n_in %d out %d ws %zu need %zu)\n", n_in, out_size, ws_size, (size_t)WS_NEED); grid_blocks = -1; return; }
        int dev = 0, cus = 0, per_cu = 0;
        (void)hipGetDevice(&dev);
        (void)hipDeviceGetAttribute(&cus, hipDeviceAttributeMultiprocessorCount, dev);
        if (hipFuncSetAttribute((const void*)fwd_megakernel, hipFuncAttributeMaxDynamicSharedMemorySize, LDS_BYTES) != hipSuccess) { fprintf(stderr, "kernel_launch: hipFuncSetAttribute failed\n"); grid_blocks = -1; return; }
        (void)hipOccupancyMaxActiveBlocksPerMultiprocessor(&per_cu, (const void*)fwd_megakernel, 512, LDS_BYTES);
        if (per_cu < 1) per_cu = 1;
        grid_blocks = cus * per_cu;
        if (grid_blocks > 256) grid_blocks = 256;
    }
    if (grid_blocks < 0) return;
    (void)hipMemsetAsync((unsigned char*)d_ws + WS_MISC + MO_CTL, 0, 4096, stream);
    Params p{};
    for (int i = 0; i < 34; ++i) p.in[i] = (const float*)d_in[i];
    p.out = (float*)d_out; p.ws = (unsigned char*)d_ws;
    void* args[] = {&p};
    hipError_t e = hipLaunchCooperativeKernel((const void*)fwd_megakernel, dim3(grid_blocks), dim3(512), args, LDS_BYTES, stream);
    if (e != hipSuccess) fprintf(stderr, "cooperative launch failed: %s (grid %d)\n", hipGetErrorString(e), grid_blocks);
}
```
